# Optimizing an MI355X kernel written in HIP

```python
import math
import jax, jax.numpy as jnp
from jax import lax
import numpy as np

D_MODEL = 1024
BATCH = 8
SEQ = 4096
DEPTH = 4

CHUNK = 64
Q_BLOCK = 128
MIX_WIDTH = D_MODEL
ATT_WIDTH = MIX_WIDTH // 2
REC_WIDTH = MIX_WIDTH - ATT_WIDTH
H_A = 4
D_A = ATT_WIDTH // (2 * H_A)
H_R = 4
D_K = REC_WIDTH // H_R
D_V = REC_WIDTH // H_R
D_FF = 4 * D_MODEL
NUM_BUCKETS = 32
MAX_DISTANCE = 128
IN_COLS = 3 * ATT_WIDTH + 4 * REC_WIDTH
EPS = 1e-6
NEG_INF = -1e30

kernel_name = "hymba_diffattn_hgrn2_trunk"


def rms_norm(x, g):
    xf = x.astype(jnp.float32)
    y = xf * lax.rsqrt(jnp.mean(xf * xf, axis=-1, keepdims=True) + EPS)
    return (y * g.astype(jnp.float32)).astype(x.dtype)


def t5_bucket(rel):
    n_half = NUM_BUCKETS // 2
    max_exact = n_half // 2
    ret = jnp.where(rel > 0, n_half, 0)
    n = jnp.abs(rel)
    nf = jnp.maximum(n, 1).astype(jnp.float32)
    large = max_exact + (jnp.log(nf / max_exact) / math.log(MAX_DISTANCE / max_exact)
                         * (n_half - max_exact)).astype(jnp.int32)
    large = jnp.minimum(large, n_half - 1)
    return ret + jnp.where(n < max_exact, n, large)


def diff_attention(q1, q2, k1, k2, v, lam, rel_bias):
    B, H, S, d = q1.shape
    nblk = S // Q_BLOCK
    scale = d ** -0.5
    kpos = jnp.arange(S)

    def block(args):
        i, qa, qb = args
        qpos = i * Q_BLOCK + jnp.arange(Q_BLOCK)
        allowed = (kpos[None, :] // CHUNK) <= (qpos[:, None] // CHUNK)
        bias = rel_bias[t5_bucket(kpos[None, :] - qpos[:, None])]
        bias = jnp.transpose(bias, (2, 0, 1)).astype(jnp.float32)

        def probs(qx, kx):
            s = jnp.einsum('bhqd,bhkd->bhqk', qx, kx).astype(jnp.float32) * scale + bias
            s = jnp.where(allowed, s, NEG_INF)
            return jax.nn.softmax(s, axis=-1)

        p = probs(qa, k1) - lam * probs(qb, k2)
        return jnp.einsum('bhqk,bhkv->bhqv', p.astype(v.dtype), v)

    to_blocks = lambda t: t.reshape(B, H, nblk, Q_BLOCK, d).transpose(2, 0, 1, 3, 4)
    out = lax.map(block, (jnp.arange(nblk), to_blocks(q1), to_blocks(q2)))
    return out.transpose(1, 2, 0, 3, 4).reshape(B, H, S, v.shape[-1])


def hgrn2_chunked(q, g, k, v):
    B, H, S, dk = q.shape
    dv = v.shape[-1]
    nC = S // CHUNK
    to_chunks = lambda t: t.reshape(B, H, nC, CHUNK, t.shape[-1]).transpose(2, 0, 1, 3, 4)
    tri = jnp.tril(jnp.ones((CHUNK, CHUNK), dtype=bool))

    def step(state, inp):
        qc, gc, kc, vc = inp
        bc = jnp.cumsum(gc, axis=-2)
        inter = jnp.einsum('bhtk,bhkv->bhtv', qc * jnp.exp(bc), state)
        diff = bc[:, :, :, None, :] - bc[:, :, None, :, :]
        decay = jnp.exp(jnp.where(tri[:, :, None], diff, -jnp.inf))
        attn = jnp.einsum('bhtk,bhtsk,bhsk->bhts', qc, decay, kc)
        intra = jnp.einsum('bhts,bhsv->bhtv', attn, vc)
        blast = bc[:, :, -1:, :]
        state = (jnp.exp(blast[:, :, 0, :])[..., None] * state
                 + jnp.einsum('bhsk,bhsv->bhkv', kc * jnp.exp(blast - bc), vc))
        return state, inter + intra

    state0 = jnp.zeros((B, H, dk, dv), jnp.float32)
    _, out = lax.scan(step, state0, (to_chunks(q), to_chunks(g), to_chunks(k), to_chunks(v)))
    return out.transpose(1, 2, 0, 3, 4).reshape(B, H, S, dv)


def setup_inputs(seed: int = 0) -> dict:
    key = jax.random.key(seed)
    ks = jax.random.split(key, 16)
    nrm = lambda k, shape, s: jax.random.normal(k, shape, jnp.float32) * s
    return {
        "x": nrm(ks[0], (BATCH, SEQ, D_MODEL), 1.0),
        "norm1_g": 1.0 + nrm(ks[1], (DEPTH, D_MODEL), 0.02),
        "w_in": nrm(ks[2], (DEPTH, D_MODEL, IN_COLS), D_MODEL ** -0.5),
        "lam_qk": nrm(ks[3], (DEPTH, 4, D_A), 0.1),
        "attn_norm_g": 1.0 + nrm(ks[4], (DEPTH, 2 * D_A), 0.02),
        "lb_logits": nrm(ks[5], (DEPTH, REC_WIDTH), 0.1),
        "hgrn_norm_g": 1.0 + nrm(ks[6], (DEPTH, D_V), 0.02),
        "w_out": nrm(ks[7], (DEPTH, MIX_WIDTH, D_MODEL), MIX_WIDTH ** -0.5),
        "norm2_g": 1.0 + nrm(ks[8], (DEPTH, D_MODEL), 0.02),
        "w_up": nrm(ks[9], (DEPTH, D_MODEL, D_FF), D_MODEL ** -0.5),
        "w_down": nrm(ks[10], (DEPTH, D_FF, D_MODEL), D_FF ** -0.5),
        "rel_bias": nrm(ks[11], (NUM_BUCKETS, H_A), 0.5),
        "final_g": 1.0 + nrm(ks[12], (D_MODEL,), 0.02),
    }


def reference(x, norm1_g, w_in, lam_qk, attn_norm_g, lb_logits, hgrn_norm_g,
              w_out, norm2_g, w_up, w_down, rel_bias, final_g):
    B, S, _ = x.shape
    lb_all = jnp.cumsum(jax.nn.softmax(lb_logits.astype(jnp.float32), axis=0), axis=0)
    lb_all = lb_all - lb_all[0:1]

    for l in range(DEPTH):
        h = rms_norm(x, norm1_g[l])
        z = jnp.einsum('bsd,dc->bsc', h, w_in[l])
        aq, ak, av, rq, rf, ri, rg = jnp.split(
            z, np.cumsum([ATT_WIDTH] * 3 + [REC_WIDTH] * 3).tolist(), axis=-1)

        qh = aq.reshape(B, S, H_A, 2, D_A).transpose(0, 2, 1, 3, 4)
        kh = ak.reshape(B, S, H_A, 2, D_A).transpose(0, 2, 1, 3, 4)
        vh = av.reshape(B, S, H_A, 2 * D_A).transpose(0, 2, 1, 3)
        lam_init = 0.8 - 0.6 * math.exp(-0.3 * l)
        lq = lam_qk[l].astype(jnp.float32)
        lam = jnp.exp(jnp.sum(lq[0] * lq[1])) - jnp.exp(jnp.sum(lq[2] * lq[3])) + lam_init
        oa = diff_attention(qh[..., 0, :], qh[..., 1, :], kh[..., 0, :], kh[..., 1, :],
                            vh, lam, rel_bias)
        oa = rms_norm(oa, attn_norm_g[l]) * (1.0 - lam_init)
        oa = oa.transpose(0, 2, 1, 3).reshape(B, S, ATT_WIDTH)

        lb = lb_all[l].reshape(H_R, D_K)[None, :, None, :]
        to_heads = lambda t, d: t.reshape(B, S, H_R, d).transpose(0, 2, 1, 3).astype(jnp.float32)
        rf_h = to_heads(rf, D_K)
        log_f = jnp.logaddexp(jnp.log(lb), jnp.log1p(-lb) + jax.nn.log_sigmoid(rf_h))
        k_in = -jnp.expm1(log_f)
        q_r = jax.nn.silu(to_heads(rq, D_K))
        orr = hgrn2_chunked(q_r, log_f, k_in, to_heads(ri, D_V))
        orr = rms_norm(orr.transpose(0, 2, 1, 3), hgrn_norm_g[l]).reshape(B, S, REC_WIDTH)
        orr = orr.astype(x.dtype) * jax.nn.silu(rg)

        mixed = jnp.concatenate([oa.astype(x.dtype), orr], axis=-1)
        x = x + jnp.einsum('bsc,cd->bsd', mixed, w_out[l])

        h2 = rms_norm(x, norm2_g[l])
        u = jax.nn.relu(jnp.einsum('bsd,df->bsf', h2, w_up[l]))
        x = x + jnp.einsum('bsf,fd->bsd', u * u, w_down[l])

    return rms_norm(x, final_g)
```

```cpp
#include <hip/hip_runtime.h>
#include <hip/hip_cooperative_groups.h>
#include <cstdio>
#include <cstdint>
namespace cg = cooperative_groups;
namespace pg8 {
#define PG8_LAS __attribute__((address_space(3)))
typedef unsigned short bf16_t;
typedef short bf16x8 __attribute__((ext_vector_type(8)));
typedef float f32x4 __attribute__((ext_vector_type(4)));
typedef unsigned u32x4 __attribute__((ext_vector_type(4)));
constexpr int BM = 256, BK = 64, HALF = 128, HTB = HALF * BK * 2  , STAGE_BYTES = 8 * HTB, NXCD = 8, WGM = 8;

__host__ __device__ __forceinline__ int lds_byte(int r, int c) { const int st = (r >> 4) * 2 + (c >> 5), rr = r & 15, cc = c & 31, ob = rr * 64 + cc * 2; return st * 1024 + (ob ^ (((ob >> 9) & 1) << 5)); }
__host__ __device__ __forceinline__ void stage_rc(int b, int& R, int& C) { const int st = b / 1024, sb = b % 1024, swz = sb ^ (((sb >> 9) & 1) << 5); R = (st >> 1) * 16 + swz / 64; C = (st & 1) * 32 + (swz % 64) / 2; }
__host__ __device__ __forceinline__ int perm32(int rho) { const int n = rho >> 4, i = rho & 15; return 8 * (i >> 2) + 4 * n + (i & 3); }

struct Unit { int pm, pn; };
struct Gemm { const bf16_t* A; const bf16_t* Bt; int M, N, K; int ablk; };

struct StaticOrder {
    int nM, nN, nwg, G, c, rev, pm0;
    __host__ __device__ void init(int M, int N, int G_, int c_, int rev_ = 0, int pm0_ = 0) { nM = M / BM; nN = N / BM; nwg = nM * nN; G = G_; c = c_; rev = (rev_ && nwg % G_ == 0) ? 1 : 0; pm0 = pm0_; }
    __host__ __device__ bool next(int i, Unit& u) const {
        if (rev && i >= nwg / G) return false;
        const long L = (long)(rev ? nwg / G - 1 - i : i) * G + c; if (L >= nwg) return false;
        int wgid = (int)L; { const int q = nwg / NXCD, r = nwg % NXCD, xcd = wgid % NXCD, off = wgid / NXCD; wgid = (xcd < r ? xcd * (q + 1) : r * (q + 1) + (xcd - r) * q) + off; }
        const int nig = WGM * nN, gid = wgid / nig, fm = gid * WGM, gsz = (nM - fm) < WGM ? (nM - fm) : WGM;
        u.pm = pm0 + fm + ((wgid % nig) % gsz); u.pn = (wgid % nig) / gsz; return true;
    }
    __device__ __forceinline__ void a_ready(const Unit&) const {}
    __device__ __forceinline__ void done(const Unit&) const {}
};

__device__ __forceinline__ unsigned cvt_pk_bf16(float lo, float hi) { unsigned r; asm volatile("v_cvt_pk_bf16_f32 %0, %1, %2" : "=v"(r) : "v"(lo), "v"(hi)); return r; }
typedef float f32x2 __attribute__((ext_vector_type(2)));
typedef unsigned u32x2 __attribute__((ext_vector_type(2)));
typedef _Float16 h16x8 __attribute__((ext_vector_type(8)));
__device__ __forceinline__ float silu_f(float x) { return x * __builtin_amdgcn_rcpf(1.0f + __expf(-x)); }
constexpr float SS_FIX = 1048576.0f, SS_INV = 1.0f / (1024.0f * 1048576.0f);
constexpr float QSCALE = 0.125f * 1.4426950408889634f;

struct EpiAny {
    static constexpr bool PERM = true, AFTER_DRAIN = false;
    int mode;
    bf16_t* Z; _Float16* G; const unsigned long long* ss; const float* lb;
    bf16_t* xb; unsigned long long* ssn; float ascale;
    __device__ __forceinline__ void operator()(const f32x4 (&acc)[2][2][4][2], const Unit& u, int wr, int wc, int fr, int fq) const {
        if (mode == 0) epi_in(acc, u, wr, wc, fr, fq); else if (mode == 1) epi_res(acc, u, wr, wc, fr, fq); else epi_up(acc, u, wr, wc, fr, fq);
    }
    __device__ __forceinline__ void epi_in(const f32x4 (&acc)[2][2][4][2], const Unit& u, int wr, int wc, int fr, int fq) const {
        const int row0 = u.pm * BM + wr * 64 + fr;
        const int grp = u.pn >> 1;
        const int cin = wc * 32 + 8 * fq;
        const int zc0 = (grp < 4 ? u.pn : u.pn - 2) * BM + cin;
        const int gc0 = (u.pn - 8) * BM + cin;
#pragma unroll
        for (int ai = 0; ai < 2; ++ai)
#pragma unroll
            for (int m = 0; m < 4; ++m) {
                const int row = row0 + ai * HALF + m * 16;
                const float rs = rsqrtf((float)ss[row] * SS_INV + 1e-6f);
#pragma unroll
                for (int bj = 0; bj < 2; ++bj) {
                    f32x4 v0 = acc[ai][bj][m][0] * rs, v1 = acc[ai][bj][m][1] * rs;
                    if (grp == 4) {
                        const int gc = gc0 + bj * HALF;
                        const f32x4 l0 = *(const f32x4*)(lb + gc), l1 = *(const f32x4*)(lb + gc + 4);
                        f32x4 o0, o1;
#pragma unroll
                        for (int j = 0; j < 4; ++j) {
                            o0[j] = __logf(l0[j] + (1.0f - l0[j]) * __builtin_amdgcn_rcpf(1.0f + __expf(-v0[j])));
                            o1[j] = __logf(l1[j] + (1.0f - l1[j]) * __builtin_amdgcn_rcpf(1.0f + __expf(-v1[j])));
                        }
                        h16x8 hv;
#pragma unroll
                        for (int j = 0; j < 4; ++j) { hv[j] = (_Float16)o0[j]; hv[4 + j] = (_Float16)o1[j]; }
                        *(h16x8*)(G + (size_t)row * 512 + gc) = hv;
                    } else {
                        if (grp == 0) { v0 = v0 * QSCALE; v1 = v1 * QSCALE; }
                        else if (grp == 3 || grp == 6) {
#pragma unroll
                            for (int j = 0; j < 4; ++j) { v0[j] = silu_f(v0[j]); v1[j] = silu_f(v1[j]); }
                        }
                        u32x4 w; w.x = cvt_pk_bf16(v0[0], v0[1]); w.y = cvt_pk_bf16(v0[2], v0[3]); w.z = cvt_pk_bf16(v1[0], v1[1]); w.w = cvt_pk_bf16(v1[2], v1[3]);
                        *(u32x4*)(Z + (size_t)row * 3072 + zc0 + bj * HALF) = w;
                    }
                }
            }
    }

    __device__ __forceinline__ void epi_res(const f32x4 (&acc)[2][2][4][2], const Unit& u, int wr, int wc, int fr, int fq) const {
        const int row0 = u.pm * BM + wr * 64 + fr;
        const int col0 = u.pn * BM + wc * 32 + 8 * fq;
#pragma unroll
        for (int ai = 0; ai < 2; ++ai) {
            u32x4 xo[4][2];
#pragma unroll
            for (int m = 0; m < 4; ++m)
#pragma unroll
                for (int bj = 0; bj < 2; ++bj) xo[m][bj] = *(const u32x4*)(xb + (size_t)(row0 + ai * HALF + m * 16) * 1024 + col0 + bj * HALF);
#pragma unroll
            for (int m = 0; m < 4; ++m) {
                const int row = row0 + ai * HALF + m * 16;
                float sq = 0.f;
#pragma unroll
                for (int bj = 0; bj < 2; ++bj) {
                    const u32x4 xw = xo[m][bj];
                    const f32x4 x0 = {__uint_as_float(xw.x << 16), __uint_as_float(xw.x & 0xffff0000u), __uint_as_float(xw.y << 16), __uint_as_float(xw.y & 0xffff0000u)};
                    const f32x4 x1 = {__uint_as_float(xw.z << 16), __uint_as_float(xw.z & 0xffff0000u), __uint_as_float(xw.w << 16), __uint_as_float(xw.w & 0xffff0000u)};
                    const f32x4 n0 = x0 + acc[ai][bj][m][0] * ascale, n1 = x1 + acc[ai][bj][m][1] * ascale;
                    u32x4 w; w.x = cvt_pk_bf16(n0[0], n0[1]); w.y = cvt_pk_bf16(n0[2], n0[3]); w.z = cvt_pk_bf16(n1[0], n1[1]); w.w = cvt_pk_bf16(n1[2], n1[3]);
                    *(u32x4*)(xb + (size_t)row * 1024 + col0 + bj * HALF) = w;
                    sq += ((n0[0] * n0[0] + n0[1] * n0[1]) + (n0[2] * n0[2] + n0[3] * n0[3])) + ((n1[0] * n1[0] + n1[1] * n1[1]) + (n1[2] * n1[2] + n1[3] * n1[3]));
                }
                sq += __shfl_xor(sq, 16); sq += __shfl_xor(sq, 32);
                if (fq == 0) __hip_atomic_fetch_add(ssn + row, (unsigned long long)(sq * SS_FIX), __ATOMIC_RELAXED, __HIP_MEMORY_SCOPE_AGENT);
            }
        }
    }

    __device__ __forceinline__ void epi_up(const f32x4 (&acc)[2][2][4][2], const Unit& u, int wr, int wc, int fr, int fq) const {
        const int row0 = u.pm * BM + wr * 64 + fr;
        const int col0 = u.pn * BM + wc * 32 + 8 * fq;
#pragma unroll
        for (int ai = 0; ai < 2; ++ai)
#pragma unroll
            for (int m = 0; m < 4; ++m) {
                const int row = row0 + ai * HALF + m * 16;
                const float rs = rsqrtf((float)ss[row] * SS_INV + 1e-6f);
#pragma unroll
                for (int bj = 0; bj < 2; ++bj) {
                    f32x4 v0 = acc[ai][bj][m][0] * rs, v1 = acc[ai][bj][m][1] * rs;
#pragma unroll
                    for (int j = 0; j < 4; ++j) { const float a = fmaxf(v0[j], 0.f), b = fmaxf(v1[j], 0.f); v0[j] = a * a; v1[j] = b * b; }
                    u32x4 w; w.x = cvt_pk_bf16(v0[0], v0[1]); w.y = cvt_pk_bf16(v0[2], v0[3]); w.z = cvt_pk_bf16(v1[0], v1[1]); w.w = cvt_pk_bf16(v1[2], v1[3]);
                    { const int col = col0 + bj * HALF;
                      *(u32x4*)(Z + ((size_t)((row >> 8) * 64 + (col >> 6)) * 256 + (row & 255)) * 64 + (col & 63)) = w; }
                }
            }
    }
};

template <class Epi, class Sched, bool ALIGN_EPI = false, bool SP2 = false>
__device__ __forceinline__ void gemm_phase(PG8_LAS unsigned char* lds, const Gemm g, const Sched& S, const Epi& E) {
    const int tid = threadIdx.x, wid = __builtin_amdgcn_readfirstlane(tid >> 6), lane = tid & 63, wr = wid >> 2, wc = wid & 3, fr = lane & 15, fq = lane >> 4;
    const int K = g.K, nt = K / BK;
    const int ldA = g.ablk ? BK : K;
    unsigned voffA[2], voffB[2];
#pragma unroll
    for (int i = 0; i < 2; ++i) { int R, C; stage_rc(tid * 16 + i * 8192, R, C); const int Rb = Epi::PERM ? ((R & ~31) + perm32(R & 31)) : R;
        voffA[i] = (unsigned)(R * ldA + C) * 2u; voffB[i] = (unsigned)(Rb * K + C) * 2u; }
    const size_t kstep = (size_t)(BK * 2);
    const size_t hstep = (size_t)HALF * K * 2;
    const size_t tstep = 2 * hstep;
    const size_t kstepA = g.ablk ? (size_t)BM * BK * 2 : kstep, hstepA = g.ablk ? (size_t)HALF * BK * 2 : hstep, tstepA = g.ablk ? (size_t)(K / BK) * BM * BK * 2 : tstep;
    const unsigned ldsw = (unsigned)wid * 1024u;
    const int aoff = lds_byte(wr * 64 + fr, fq * 8), boff = lds_byte(wc * 32 + fr, fq * 8);
#define PG8_SA(b, h) (((b) * 2 + (h)) * HTB)
#define PG8_SB(b, h) ((4 + (b) * 2 + (h)) * HTB)
#define PG8_STAGE(bufoff, gbase, voff) do { _Pragma("unroll") for (int _i = 0; _i < 2; ++_i) \
        __builtin_amdgcn_global_load_lds((const unsigned*)((const char*)(gbase) + (voff)[_i]), (PG8_LAS unsigned*)(lds + (bufoff) + ldsw + _i * 8192), 16, 0, 0); } while (0)
#define PG8_LDA(dst, b, h) do { _Pragma("unroll") for (int m = 0; m < 4; ++m) _Pragma("unroll") for (int k = 0; k < 2; ++k) dst[m][k] = *(const PG8_LAS bf16x8*)(lds + PG8_SA(b, h) + aoff + m * 2048 + k * 1024); } while (0)
#define PG8_LDB(dst, b, h) do { _Pragma("unroll") for (int n = 0; n < 2; ++n) _Pragma("unroll") for (int k = 0; k < 2; ++k) dst[n][k] = *(const PG8_LAS bf16x8*)(lds + PG8_SB(b, h) + boff + n * 2048 + k * 1024); } while (0)
#define PG8_MMA(ai, bj, At, Bt) do { __builtin_amdgcn_s_setprio(1); _Pragma("unroll") for (int m = 0; m < 4; ++m) _Pragma("unroll") for (int n = 0; n < 2; ++n) _Pragma("unroll") for (int k = 0; k < 2; ++k) \
        acc[ai][bj][m][n] = __builtin_amdgcn_mfma_f32_16x16x32_bf16(Bt[n][k], At[m][k], acc[ai][bj][m][n], 0, 0, 0); __builtin_amdgcn_s_setprio(0); } while (0)
#define PG8_WAIT_V(n) asm volatile("s_waitcnt vmcnt(" #n ")" ::: "memory")
#define PG8_WAIT_L(n) asm volatile("s_waitcnt lgkmcnt(" #n ")" ::: "memory")
#define PG8_BAR __builtin_amdgcn_s_barrier()
#define PG8_SCHED __builtin_amdgcn_sched_barrier(0)
    Unit cur, nxt; int ui = 0;
    if (!S.next(0, cur)) return;
    f32x4 acc[2][2][4][2];
#pragma unroll
    for (int a = 0; a < 2; ++a)
#pragma unroll
        for (int b = 0; b < 2; ++b)
#pragma unroll
            for (int m = 0; m < 4; ++m)
#pragma unroll
                for (int n = 0; n < 2; ++n) acc[a][b][m][n] = (f32x4){0.f, 0.f, 0.f, 0.f};
    bf16x8 At[4][2], B0[2][2], B1[2][2];
    const char* cA = (const char*)g.A + (size_t)cur.pm * tstepA; const char* cB = (const char*)g.Bt + (size_t)cur.pn * tstep;
    S.a_ready(cur);
    if constexpr (SP2) {
        PG8_STAGE(PG8_SB(0, 0), cB, voffB); PG8_STAGE(PG8_SB(0, 1), cB + hstep, voffB); PG8_STAGE(PG8_SA(0, 0), cA, voffA); PG8_STAGE(PG8_SA(0, 1), cA + hstepA, voffA);
        if (wr == 1) PG8_BAR;
        PG8_WAIT_V(2); PG8_BAR;
        PG8_STAGE(PG8_SB(1, 0), cB + kstep, voffB); PG8_STAGE(PG8_SA(1, 0), cA + kstepA, voffA); PG8_STAGE(PG8_SB(1, 1), cB + hstep + kstep, voffB);
        PG8_WAIT_V(6); PG8_BAR;
    } else {
        PG8_STAGE(PG8_SB(0, 0), cB, voffB); PG8_STAGE(PG8_SA(0, 0), cA, voffA); PG8_STAGE(PG8_SB(0, 1), cB + hstep, voffB); PG8_STAGE(PG8_SA(0, 1), cA + hstepA, voffA);
        if (wr == 1) PG8_BAR;
        PG8_WAIT_V(4); PG8_BAR;
        PG8_STAGE(PG8_SB(1, 0), cB + kstep, voffB); PG8_STAGE(PG8_SA(1, 0), cA + kstepA, voffA); PG8_STAGE(PG8_SB(1, 1), cB + hstep + kstep, voffB);
        PG8_WAIT_V(6); PG8_BAR;
    }
    for (;;) {
        const bool has_next = S.next(ui + 1, nxt);
        const char* nA = has_next ? (const char*)g.A + (size_t)nxt.pm * tstepA : cA; const char* nB = has_next ? (const char*)g.Bt + (size_t)nxt.pn * tstep : cB;
        for (int t = 0; t < nt; t += 2) {
            const bool last = (t == nt - 2);
            const char* a1 = cA + (size_t)(t + 1) * kstepA;
            const char* a2 = last ? nA : cA + (size_t)(t + 2) * kstepA; const char* b2 = last ? nB : cB + (size_t)(t + 2) * kstep;
            const char* a3 = a2 + kstepA; const char* b3 = b2 + kstep;
            if (last && has_next) S.a_ready(nxt);
            if constexpr (SP2) {
            PG8_LDB(B0, 0, 0); PG8_LDB(B1, 0, 1); PG8_SCHED; PG8_LDA(At, 0, 0); PG8_STAGE(PG8_SA(1, 1), a1 + hstepA, voffA);
            PG8_WAIT_V(8); PG8_WAIT_L(0); PG8_BAR; PG8_MMA(0, 0, At, B0); PG8_MMA(0, 1, At, B1); PG8_BAR; PG8_SCHED;
            PG8_LDA(At, 0, 1); PG8_STAGE(PG8_SB(0, 0), b2, voffB); PG8_STAGE(PG8_SB(0, 1), b2 + hstep, voffB); PG8_STAGE(PG8_SA(0, 0), a2, voffA);
            PG8_WAIT_V(8); PG8_WAIT_L(0); PG8_BAR; PG8_MMA(1, 0, At, B0); PG8_MMA(1, 1, At, B1); PG8_BAR; PG8_SCHED;
            PG8_LDB(B0, 1, 0); PG8_LDB(B1, 1, 1); PG8_SCHED; PG8_LDA(At, 1, 0); PG8_STAGE(PG8_SA(0, 1), a2 + hstepA, voffA);
            PG8_WAIT_V(8); PG8_WAIT_L(0); PG8_BAR; PG8_MMA(0, 0, At, B0); PG8_MMA(0, 1, At, B1); PG8_BAR; PG8_SCHED;
            PG8_LDA(At, 1, 1); PG8_STAGE(PG8_SB(1, 0), b3, voffB); PG8_STAGE(PG8_SB(1, 1), b3 + hstep, voffB); PG8_STAGE(PG8_SA(1, 0), a3, voffA);
            PG8_WAIT_V(8); PG8_WAIT_L(0); PG8_BAR; PG8_MMA(1, 0, At, B0); PG8_MMA(1, 1, At, B1); PG8_BAR; PG8_SCHED;
            } else {
            PG8_LDB(B0, 0, 0); PG8_SCHED; PG8_LDA(At, 0, 0); PG8_STAGE(PG8_SA(1, 1), a1 + hstepA, voffA);
            PG8_WAIT_L(8); PG8_BAR; PG8_WAIT_L(0); PG8_MMA(0, 0, At, B0); PG8_BAR; PG8_SCHED;
            PG8_LDB(B1, 0, 1); PG8_STAGE(PG8_SB(0, 0), b2, voffB);
            PG8_BAR; PG8_WAIT_L(0); PG8_MMA(0, 1, At, B1); PG8_BAR;
            PG8_LDA(At, 0, 1); PG8_STAGE(PG8_SA(0, 0), a2, voffA);
            PG8_BAR; PG8_WAIT_L(0); PG8_MMA(1, 0, At, B0); PG8_BAR; PG8_SCHED;
            PG8_STAGE(PG8_SB(0, 1), b2 + hstep, voffB);
            PG8_WAIT_V(6); PG8_BAR; PG8_MMA(1, 1, At, B1); PG8_BAR;
            PG8_LDB(B0, 1, 0); PG8_SCHED; PG8_LDA(At, 1, 0); PG8_STAGE(PG8_SA(0, 1), a2 + hstepA, voffA);
            PG8_WAIT_L(8); PG8_BAR; PG8_WAIT_L(0); PG8_MMA(0, 0, At, B0); PG8_BAR; PG8_SCHED;
            PG8_LDB(B1, 1, 1); PG8_STAGE(PG8_SB(1, 0), b3, voffB);
            PG8_BAR; PG8_WAIT_L(0); PG8_MMA(0, 1, At, B1); PG8_BAR;
            PG8_LDA(At, 1, 1); PG8_STAGE(PG8_SA(1, 0), a3, voffA);
            PG8_BAR; PG8_WAIT_L(0); PG8_MMA(1, 0, At, B0); PG8_BAR; PG8_SCHED;
            PG8_STAGE(PG8_SB(1, 1), b3 + hstep, voffB);
            PG8_WAIT_V(6); PG8_BAR; PG8_MMA(1, 1, At, B1); PG8_BAR;
            }
        }
        if constexpr (ALIGN_EPI) { if (wr == 0) PG8_BAR; }
        if constexpr (!Epi::AFTER_DRAIN) { E(acc, cur, wr, wc, fr, fq); S.done(cur); }
        if (!has_next) break;
#pragma unroll
        for (int a = 0; a < 2; ++a)
#pragma unroll
            for (int b = 0; b < 2; ++b)
#pragma unroll
                for (int m = 0; m < 4; ++m)
#pragma unroll
                    for (int n = 0; n < 2; ++n) acc[a][b][m][n] = (f32x4){0.f, 0.f, 0.f, 0.f};
        cur = nxt; cA = nA; cB = nB; ++ui;
        if constexpr (ALIGN_EPI) { if (wr == 1) PG8_BAR; }
    }
    PG8_WAIT_V(0);
    if constexpr (!ALIGN_EPI) { if (wr == 0) PG8_BAR; }
    PG8_BAR;
    if constexpr (Epi::AFTER_DRAIN) { E.fused(acc, cur, wr, wc, fr, fq, lds, wid, lane); S.done(cur); }
#undef PG8_SA
#undef PG8_SB
#undef PG8_STAGE
#undef PG8_LDA
#undef PG8_LDB
#undef PG8_MMA
#undef PG8_WAIT_V
#undef PG8_WAIT_L
#undef PG8_BAR
#undef PG8_SCHED
}
}
#define LAS __attribute__((address_space(3)))
typedef LAS unsigned char* ldsp;
typedef unsigned short bf16_t;
typedef short bf16x8 __attribute__((ext_vector_type(8)));
typedef short s16x4 __attribute__((ext_vector_type(4)));
typedef float f32x4 __attribute__((ext_vector_type(4)));
typedef float f32x16 __attribute__((ext_vector_type(16)));
typedef unsigned u32x4 __attribute__((ext_vector_type(4)));
typedef unsigned u32x2 __attribute__((ext_vector_type(2)));
typedef float f32x2_t __attribute__((ext_vector_type(2)));
typedef __bf16 bf16x2_t __attribute__((ext_vector_type(2)));

constexpr int M_TOK = 32768, SEQL = 4096, DM = 1024, INC = 3584, FF = 4096, ZP = 3072, DEPTH = 4;
constexpr int NWAVES = 8, NTHR = 512;
constexpr size_t MiB = 1u << 20;
constexpr size_t WS_CTL = 0;
constexpr size_t WS_SS = 1 * MiB;
constexpr size_t WS_W = 4 * MiB;
constexpr size_t W_LAYER = 25 * MiB, W_IN = 0, W_OUT = 7 * MiB, W_UP = 9 * MiB, W_DOWN = 17 * MiB;
constexpr size_t WS_XB = 104 * MiB;
constexpr size_t WS_Z = 168 * MiB;
constexpr size_t WS_G = 360 * MiB;
constexpr size_t WS_U = 168 * MiB;
constexpr size_t WS_MIX = 424 * MiB;
constexpr size_t WS_SC = 488 * MiB;
constexpr size_t WS_END = 490 * MiB;
constexpr int CW_QCTR = 8192;
constexpr int CW_LAM = 1024;
constexpr int CW_LB = 2048;
constexpr int CW_BAR = 4096;
constexpr size_t CTL_ZERO_BYTES = 65536;
constexpr int LDS_BYTES = 147456;
constexpr float LOG2E = 1.4426950408889634f;

__device__ __forceinline__ unsigned cvtpk(float lo, float hi) { f32x2_t v = {lo, hi}; bf16x2_t b = __builtin_convertvector(v, bf16x2_t); return __builtin_bit_cast(unsigned, b); }
__device__ __forceinline__ float bf2f(unsigned short u) { return __uint_as_float((unsigned)u << 16); }
__device__ __forceinline__ int crow(int reg, int h) { return (reg & 3) + 8 * (reg >> 2) + 4 * h; }
__device__ __forceinline__ float wave_sum(float v) {
#pragma unroll
    for (int o = 1; o < 64; o <<= 1) v += __shfl_xor(v, o);
    return v;
}
#define MFMA32(a, b, c) __builtin_amdgcn_mfma_f32_32x32x16_bf16((a), (b), (c), 0, 0, 0)
__device__ __forceinline__ bf16x8 pack_step(const f32x16& x, int s) {
    u32x4 p; p.x = cvtpk(x[8 * s], x[8 * s + 1]); p.y = cvtpk(x[8 * s + 2], x[8 * s + 3]); p.z = cvtpk(x[8 * s + 4], x[8 * s + 5]); p.w = cvtpk(x[8 * s + 6], x[8 * s + 7]);
    return __builtin_bit_cast(bf16x8, p);
}
typedef short v4i16_t __attribute__((ext_vector_type(4)));
__device__ __forceinline__ s16x4 vtr(ldsp p) { return __builtin_bit_cast(s16x4, __builtin_amdgcn_ds_read_tr16_b64_v4i16((LAS v4i16_t*)p)); }

struct P0Item { const float* W; const float* gk; bf16_t* WT; int K, N, k0, n0; };
__device__ __forceinline__ void p0_load(const P0Item& d, int lane, f32x4 (&wv)[8], float (&gg)[8]) {
    const int kr = lane >> 3, nq = (lane & 7) * 4;
#pragma unroll
    for (int i = 0; i < 8; ++i) { const int kk = 8 * i + kr; wv[i] = *(const f32x4*)(d.W + (size_t)(d.k0 + kk) * d.N + d.n0 + nq); gg[i] = d.gk ? d.gk[d.k0 + kk] : 1.0f; }
}
__device__ __forceinline__ void p0_store(const P0Item& d, int lane, LAS float* scr, const f32x4 (&wv)[8], const float (&gg)[8]) {
    const int kr = lane >> 3, nq = (lane & 7) * 4;
#pragma unroll
    for (int i = 0; i < 8; ++i) { const int kk = 8 * i + kr;
#pragma unroll
        for (int j = 0; j < 4; ++j) scr[kk * 33 + nq + j] = wv[i][j] * gg[i]; }
    asm volatile("s_waitcnt lgkmcnt(0)" ::: "memory");
    const int c = lane & 7;
#pragma unroll
    for (int j = 0; j < 4; ++j) { const int n = (lane >> 3) + 8 * j; const LAS float* sp = scr + (8 * c) * 33 + n;
        u32x4 o; o.x = cvtpk(sp[0 * 33], sp[1 * 33]); o.y = cvtpk(sp[2 * 33], sp[3 * 33]); o.z = cvtpk(sp[4 * 33], sp[5 * 33]); o.w = cvtpk(sp[6 * 33], sp[7 * 33]);
        *(u32x4*)(d.WT + (size_t)(d.n0 + n) * d.K + d.k0 + 8 * c) = o; }
    asm volatile("s_waitcnt lgkmcnt(0)" ::: "memory");
}

struct Args { const float* in[13]; float* out; unsigned char* ws; };
__device__ __forceinline__ P0Item p0_decode(const Args& args, unsigned char* ws, int it) {
    constexpr int I_IN = (DM / 64) * (INC / 32), I_OUT = (DM / 64) * (DM / 32), I_UP = (DM / 64) * (FF / 32), I_DN = (FF / 64) * (DM / 32), I_L = I_IN + I_OUT + I_UP + I_DN;
    const int l = it / I_L; int rr = it % I_L;
    unsigned char* wl = ws + WS_W + (size_t)l * W_LAYER;
    P0Item d;
    if (rr < I_IN) { d.W = args.in[2] + (size_t)l * DM * INC; d.gk = args.in[1] + l * DM; d.WT = (bf16_t*)(wl + W_IN); d.K = DM; d.N = INC; }
    else if ((rr -= I_IN) < I_OUT) { d.W = args.in[7] + (size_t)l * DM * DM; d.gk = nullptr; d.WT = (bf16_t*)(wl + W_OUT); d.K = DM; d.N = DM; }
    else if ((rr -= I_OUT) < I_UP) { d.W = args.in[9] + (size_t)l * DM * FF; d.gk = args.in[8] + l * DM; d.WT = (bf16_t*)(wl + W_UP); d.K = DM; d.N = FF; }
    else { rr -= I_UP; d.W = args.in[10] + (size_t)l * FF * DM; d.gk = nullptr; d.WT = (bf16_t*)(wl + W_DOWN); d.K = FF; d.N = DM; }
    const int nblk = d.N / 32; d.k0 = 64 * (rr / nblk); d.n0 = 32 * (rr % nblk);
    return d;
}


constexpr int AT_KP = 272, AT_VP = 320, AT_KB = 64 * AT_KP, AT_VB = 64 * AT_VP;
constexpr int AT_K0 = 0, AT_V0 = 2 * AT_KB, AT_BIAS = AT_V0 + 2 * AT_VB, AT_EX = 0;
static_assert(AT_BIAS >= 65536 && AT_BIAS + 4096 <= LDS_BYTES - 32, "attention LDS map");
__device__ __forceinline__ void attn_bias_tables(ldsp lds, const float* relb) {
    for (int e = threadIdx.x; e < 1024; e += NTHR) {
        const int h = e >> 8, rel = (e & 255) - 192, n = rel < 0 ? -rel : rel;
        int bk = rel > 0 ? 16 : 0;
        if (n < 8) bk += n;
        else { int lg = 8 + (int)(2.0f * __log2f((float)n * 0.125f) + 1e-4f); bk += lg < 15 ? lg : 15; }
        *(LAS float*)(lds + AT_BIAS + 4 * e) = (relb[bk * 4 + h] - relb[15 * 4 + h]) * LOG2E;
    }
}

template <int PB>
__device__ __forceinline__ void attn_unit(ldsp lds, int b, int h, int qb, const bf16_t* Z, bf16_t* MIX, const float* relb, const float* gnorm, float lam, float oscale) {
    int tid = threadIdx.x; asm volatile("" : "+v"(tid));
    const int lane = tid & 63, w = __builtin_amdgcn_readfirstlane(tid >> 6), r = lane & 31, hh = lane >> 5, i16 = lane & 15;
    const int wq = w & 3, map = w >> 2;
    const int rowbase = b * SEQL, q0 = qb * 128, qw = q0 + 32 * wq, ntiles = 2 * qb + 2, my_last = qw >> 6;
    bf16x8 qf[4];
    { const bf16_t* qp = Z + (size_t)(rowbase + qw + r) * ZP + h * 128 + map * 64 + 8 * hh;
#pragma unroll
      for (int d0 = 0; d0 < 4; ++d0) qf[d0] = *(const bf16x8*)(qp + 16 * d0); }
    const int srow0 = tid >> 4, scc = tid & 15;
    const bf16_t* kg = Z + (size_t)rowbase * ZP + 512 + h * 128 + scc * 8;
    const bf16_t* vg = Z + (size_t)rowbase * ZP + 1024 + h * 128 + scc * 8;
    u32x4 kr[2], vr[2];
#define AT_LOAD(kt) do { _Pragma("unroll") for (int i_ = 0; i_ < 2; ++i_) { const size_t ro_ = (size_t)((kt) * 64 + srow0 + 32 * i_) * ZP; kr[i_] = *(const u32x4*)(kg + ro_); vr[i_] = *(const u32x4*)(vg + ro_); } } while (0)
#define AT_STORE(buf) do { _Pragma("unroll") for (int i_ = 0; i_ < 2; ++i_) { const int row_ = srow0 + 32 * i_; \
        *(LAS u32x4*)(lds + AT_K0 + (buf) * AT_KB + row_ * AT_KP + scc * 16) = kr[i_]; *(LAS u32x4*)(lds + AT_V0 + (buf) * AT_VB + row_ * AT_VP + scc * 16) = vr[i_]; } } while (0)
    AT_LOAD(0); AT_STORE(0);
    __syncthreads();
    float mrun = 0.f, lrun = 0.f;
    f32x16 o[4], negm;
#pragma unroll
    for (int j = 0; j < 16; ++j) negm[j] = 0.f;
#pragma unroll
    for (int i = 0; i < 4; ++i)
#pragma unroll
        for (int j = 0; j < 16; ++j) o[i][j] = 0.f;
    for (int kt = 0; kt < ntiles; ++kt) {
        const bool more = (kt + 1 < ntiles);
        if (more && !(PB & 8)) AT_LOAD(kt + 1);
        if (kt <= my_last) {
            const ldsp Kb = lds + AT_K0 + (kt & 1) * AT_KB + r * AT_KP + (map * 64 + 8 * hh) * 2;
            const ldsp Vb = lds + AT_V0 + (kt & 1) * AT_VB + (4 * hh + (i16 >> 2)) * AT_VP + (16 * ((lane >> 4) & 1) + 4 * (i16 & 3)) * 2;
            f32x16 s0, s1;
#pragma unroll
            for (int d0 = 0; d0 < 4; ++d0) {
                const bf16x8 k0f = *(const LAS bf16x8*)(Kb + d0 * 32), k1f = *(const LAS bf16x8*)(Kb + 32 * AT_KP + d0 * 32);
                if (d0 == 0) { s0 = MFMA32(k0f, qf[0], negm); s1 = MFMA32(k1f, qf[0], negm); }
                else { s0 = MFMA32(k0f, qf[d0], s0); s1 = MFMA32(k1f, qf[d0], s1); }
            }
            if (64 * kt + 153 >= qw) {
                const int base = 64 * kt - (qw + r) + 192 + 4 * hh;
#pragma unroll
                for (int j = 0; j < 16; ++j) { int i0 = base + (j & 3) + 8 * (j >> 2); int i1 = i0 + 32; i0 = i0 < 0 ? 0 : i0; i1 = i1 < 0 ? 0 : i1;
                    s0[j] += *(const LAS float*)(lds + AT_BIAS + h * 1024 + 4 * i0); s1[j] += *(const LAS float*)(lds + AT_BIAS + h * 1024 + 4 * i1); }
            }
            if (!(PB & 4)) {
            float tmax = fmaxf(s0[0], s1[0]);
#pragma unroll
            for (int j = 1; j < 16; ++j) tmax = fmaxf(tmax, fmaxf(s0[j], s1[j]));
            tmax = fmaxf(tmax, __shfl_xor(tmax, 32));
            if (kt == 0 || __any(tmax > 8.0f)) {
                const float dl = (kt == 0) ? tmax : fmaxf(tmax, 0.f);
                const float alpha = (kt == 0) ? 1.0f : __builtin_amdgcn_exp2f(-dl);
                mrun += dl; lrun *= alpha;
#pragma unroll
                for (int j = 0; j < 16; ++j) negm[j] = -mrun;
#pragma unroll
                for (int j = 0; j < 16; ++j) { s0[j] -= dl; s1[j] -= dl; }
#pragma unroll
                for (int i = 0; i < 4; ++i)
#pragma unroll
                    for (int j = 0; j < 16; ++j) o[i][j] *= alpha;
            }
            float ls = 0.f;
#pragma unroll
            for (int j = 0; j < 16; ++j) { s0[j] = __builtin_amdgcn_exp2f(s0[j]); s1[j] = __builtin_amdgcn_exp2f(s1[j]); ls += s0[j] + s1[j]; }
            lrun += ls;
            }
            if (!(PB & 2))
#pragma unroll
            for (int sub = 0; sub < 2; ++sub)
#pragma unroll
                for (int st = 0; st < 2; ++st) {
                    const bf16x8 pf = pack_step(sub ? s1 : s0, st);
                    const ldsp vp = Vb + (32 * sub + 16 * st) * AT_VP;
#pragma unroll
                    for (int blk = 0; blk < 4; ++blk) {
                        const s16x4 lo = vtr(vp + blk * 64), hi = vtr(vp + 8 * AT_VP + blk * 64);
                        const bf16x8 vf = __builtin_shufflevector(lo, hi, 0, 1, 2, 3, 4, 5, 6, 7);
                        o[blk] = MFMA32(vf, pf, o[blk]);
                    }
                }
        }
        if (more && !(PB & 8)) AT_STORE((kt + 1) & 1);
        __syncthreads();
    }
#undef AT_LOAD
#undef AT_STORE
    { const float lt = lrun + __shfl_xor(lrun, 32); const float inv = 1.0f / lt;
#pragma unroll
      for (int i = 0; i < 4; ++i)
#pragma unroll
          for (int j = 0; j < 16; ++j) o[i][j] *= inv; }
    const ldsp ex = lds + AT_EX + wq * 16384 + lane * 4;
    if (map == 1) {
#pragma unroll
        for (int i = 0; i < 4; ++i)
#pragma unroll
            for (int j = 0; j < 16; ++j) *(LAS float*)(ex + (i * 16 + j) * 256) = o[i][j];
    }
    __syncthreads();
    if (map == 0 && !(PB & 1)) {
        float sq = 0.f;
#pragma unroll
        for (int i = 0; i < 4; ++i)
#pragma unroll
            for (int j = 0; j < 16; ++j) { const float d = o[i][j] - lam * *(const LAS float*)(ex + (i * 16 + j) * 256); o[i][j] = d; sq += d * d; }
        sq += __shfl_xor(sq, 32);
        const float rs = rsqrtf(sq * (1.0f / 128.0f) + 1e-6f) * oscale;
        bf16_t* op = MIX + (size_t)(rowbase + qw + r) * DM + h * 128 + 4 * hh;
#pragma unroll
        for (int i = 0; i < 4; ++i)
#pragma unroll
            for (int g4 = 0; g4 < 4; ++g4) {
                const int vd = 32 * i + 8 * g4;
                const f32x4 gn = *(const f32x4*)(gnorm + vd + 4 * hh);
                u32x2 wv; wv.x = cvtpk(o[i][4 * g4] * rs * gn[0], o[i][4 * g4 + 1] * rs * gn[1]); wv.y = cvtpk(o[i][4 * g4 + 2] * rs * gn[2], o[i][4 * g4 + 3] * rs * gn[3]);
                *(u32x2*)(op + vd) = wv;
            }
    }
    __syncthreads();
}

constexpr int HG_P = 272, HG_PT = 144;
constexpr int HG_QH = 0, HG_KH = 64 * HG_P, HG_KHT = 2 * 64 * HG_P, HG_VT = HG_KHT + 128 * HG_PT, HG_SS = HG_VT + 128 * HG_PT, HG_TOT = HG_SS + 128 * HG_P;
constexpr int HG_E2 = HG_TOT + 4096, HG_SSQ = HG_E2 + 512, HG_END = HG_SSQ + 1024;
static_assert(HG_END <= LDS_BYTES - 16, "hgrn LDS map");

template <int MODE>
__device__ __forceinline__ void hgrn_chunk(ldsp lds, int u0, int ustride, const bf16_t* Z, const _Float16* G, bf16_t* TS, float* SC, bf16_t* MIX, const float* gnorm, int lite = 0) {
    int tid = threadIdx.x; asm volatile("" : "+v"(tid));
    const int lane = tid & 63, w = __builtin_amdgcn_readfirstlane(tid >> 6), r = lane & 31, hh = lane >> 5;
    const int kp = (tid & 63) * 2, part = tid >> 6;
    const int vb = w >> 1, tb = w & 1;
    unsigned gr2[8], qr2[8], vr2[8]; u32x4 ssr[4];
#define HG_LOAD(uu) do { const int bh_ = (uu) >> 6, c_ = (uu) & 63, b_ = bh_ >> 2, h_ = bh_ & 3; const size_t r0_ = (size_t)b_ * SEQL + (size_t)c_ * 64 + 8 * part; \
      const unsigned* gp_ = (const unsigned*)(G + r0_ * 512 + h_ * 128 + kp); const unsigned* qp_ = (const unsigned*)(Z + r0_ * ZP + 1536 + h_ * 128 + kp); const unsigned* vp_ = (const unsigned*)(Z + r0_ * ZP + 2048 + h_ * 128 + kp); \
      _Pragma("unroll") for (int i_ = 0; i_ < 8; ++i_) { if (MODE == 3) { gr2[i_] = __builtin_nontemporal_load(gp_ + (size_t)i_ * 256); vr2[i_] = __builtin_nontemporal_load(vp_ + (size_t)i_ * (ZP / 2)); qr2[i_] = __builtin_nontemporal_load(qp_ + (size_t)i_ * (ZP / 2)); } \
        else { gr2[i_] = gp_[(size_t)i_ * 256]; vr2[i_] = vp_[(size_t)i_ * (ZP / 2)]; qr2[i_] = 0; } } \
      if (MODE == 3) { const bf16_t* sl_ = TS + (size_t)(uu) * 16384; _Pragma("unroll") for (int i_ = 0; i_ < 4; ++i_) { const int cid_ = tid + 512 * i_; ssr[i_] = __builtin_nontemporal_load((const u32x4*)(sl_ + (cid_ >> 4) * 128 + (cid_ & 15) * 8)); } } } while (0)
    if (u0 < 2048) HG_LOAD(u0);
#pragma unroll 1
    for (int u = u0; u < 2048; u += ustride) {
    const int bh = u >> 6, c = u & 63, b = bh >> 2, h = bh & 3;
    const size_t row0 = (size_t)b * SEQL + (size_t)c * 64;
    bf16_t* slot = TS + (size_t)u * 16384;
    float g0[8], g1[8], cs0[8], cs1[8];
    { float a0 = 0.f, a1 = 0.f;
#pragma unroll
      for (int i = 0; i < 8; ++i) { g0[i] = (float)__builtin_bit_cast(_Float16, (unsigned short)(gr2[i] & 0xffffu)); g1[i] = (float)__builtin_bit_cast(_Float16, (unsigned short)(gr2[i] >> 16));
          a0 += g0[i]; a1 += g1[i]; cs0[i] = a0; cs1[i] = a1; } }
    *(LAS f32x2_t*)(lds + HG_TOT + (part * 128 + kp) * 4) = (f32x2_t){cs0[7], cs1[7]};
    __syncthreads();
    { float off0 = 0.f, off1 = 0.f, rho0 = 0.f, rho1 = 0.f, bl0 = 0.f, bl1 = 0.f;
#pragma unroll
      for (int p = 0; p < 8; ++p) { const f32x2_t tt = *(const LAS f32x2_t*)(lds + HG_TOT + (p * 128 + kp) * 4);
          if (p < part) { off0 += tt.x; off1 += tt.y; }
          if (p < 4) { rho0 += tt.x; rho1 += tt.y; }
          bl0 += tt.x; bl1 += tt.y; }
      unsigned kA[4], kB[4], vA[4], vB[4];
#pragma unroll
      for (int i = 0; i < 8; i += 2) {
          const int t = 8 * part + i;
          const float b00 = off0 + cs0[i], b01 = off1 + cs1[i], b10 = off0 + cs0[i + 1], b11 = off1 + cs1[i + 1];
          const float k00 = (1.0f - __expf(g0[i])) * __expf(rho0 - b00), k01 = (1.0f - __expf(g1[i])) * __expf(rho1 - b01);
          const float k10 = (1.0f - __expf(g0[i + 1])) * __expf(rho0 - b10), k11 = (1.0f - __expf(g1[i + 1])) * __expf(rho1 - b11);
          if (MODE == 3) {
              const float q00 = __uint_as_float(qr2[i] << 16) * __expf(b00 - rho0), q01 = __uint_as_float(qr2[i] & 0xffff0000u) * __expf(b01 - rho1);
              const float q10 = __uint_as_float(qr2[i + 1] << 16) * __expf(b10 - rho0), q11 = __uint_as_float(qr2[i + 1] & 0xffff0000u) * __expf(b11 - rho1);
              *(LAS unsigned*)(lds + HG_QH + t * HG_P + kp * 2) = cvtpk(q00, q01);
              *(LAS unsigned*)(lds + HG_QH + (t + 1) * HG_P + kp * 2) = cvtpk(q10, q11);
              *(LAS unsigned*)(lds + HG_KH + t * HG_P + kp * 2) = cvtpk(k00, k01);
              *(LAS unsigned*)(lds + HG_KH + (t + 1) * HG_P + kp * 2) = cvtpk(k10, k11);
          }
          kA[i >> 1] = cvtpk(k00, k10); kB[i >> 1] = cvtpk(k01, k11);
          vA[i >> 1] = (vr2[i] & 0xffffu) | (vr2[i + 1] << 16); vB[i >> 1] = (vr2[i] >> 16) | (vr2[i + 1] & 0xffff0000u);
      }
      if (MODE == 1) {
          *(LAS u32x4*)(lds + HG_KHT + kp * HG_PT + part * 16) = (u32x4){kA[0], kA[1], kA[2], kA[3]};
          *(LAS u32x4*)(lds + HG_KHT + (kp + 1) * HG_PT + part * 16) = (u32x4){kB[0], kB[1], kB[2], kB[3]};
      }
      *(LAS u32x4*)(lds + HG_VT + kp * HG_PT + part * 16) = (u32x4){vA[0], vA[1], vA[2], vA[3]};
      *(LAS u32x4*)(lds + HG_VT + (kp + 1) * HG_PT + part * 16) = (u32x4){vB[0], vB[1], vB[2], vB[3]};
      if (MODE == 1 && part == 0) {
          *(LAS f32x2_t*)(lds + HG_E2 + kp * 4) = (f32x2_t){__expf(bl0 - rho0), __expf(bl1 - rho1)};
          *(f32x2_t*)(SC + (size_t)u * 256 + kp) = (f32x2_t){__expf(bl0), __expf(bl1)};
          *(f32x2_t*)(SC + (size_t)u * 256 + 128 + kp) = (f32x2_t){__expf(rho0), __expf(rho1)};
      }
      if (MODE == 3) {
#pragma unroll
          for (int i = 0; i < 4; ++i) { const int cid = tid + 512 * i; *(LAS u32x4*)(lds + HG_SS + (cid >> 4) * HG_P + (cid & 15) * 16) = ssr[i]; }
      }
    }
    __syncthreads();
    if (u + ustride < 2048) HG_LOAD(u + ustride);
    u32x2 gtr[4];
    if (MODE == 3) {
        const size_t grow = row0 + 32 * tb + r;
#pragma unroll
        for (int g4 = 0; g4 < 4; ++g4) gtr[g4] = __builtin_nontemporal_load((const u32x2*)(Z + grow * ZP + 2560 + h * 128 + 32 * vb + 8 * g4 + 4 * hh));
    }
    if (lite) {
    } else if (MODE == 1) {
#pragma unroll
        for (int i = 0; i < 2; ++i) {
            const int kb = 2 * tb + i;
            f32x16 T;
#pragma unroll
            for (int j = 0; j < 16; ++j) T[j] = 0.f;
#pragma unroll
            for (int s = 0; s < 4; ++s) {
                const bf16x8 af = *(const LAS bf16x8*)(lds + HG_VT + (32 * vb + r) * HG_PT + (16 * s + 8 * hh) * 2);
                const bf16x8 bfr = *(const LAS bf16x8*)(lds + HG_KHT + (32 * kb + r) * HG_PT + (16 * s + 8 * hh) * 2);
                T = MFMA32(af, bfr, T);
            }
            const float e2 = *(const LAS float*)(lds + HG_E2 + (32 * kb + r) * 4);
#pragma unroll
            for (int j = 0; j < 16; ++j) {
                const unsigned pk = cvtpk(T[j] * e2, 0.f);
                slot[(32 * vb + crow(j, hh)) * 128 + 32 * kb + r] = (unsigned short)(pk & 0xffffu);
            }
        }
    } else {
        bf16x8 qf[8];
#pragma unroll
        for (int s = 0; s < 8; ++s) qf[s] = *(const LAS bf16x8*)(lds + HG_QH + (32 * tb + r) * HG_P + (16 * s + 8 * hh) * 2);
        f32x16 at0, at1, out;
#pragma unroll
        for (int j = 0; j < 16; ++j) { at0[j] = 0.f; at1[j] = 0.f; out[j] = 0.f; }
#pragma unroll
        for (int s = 0; s < 8; ++s) { const bf16x8 kf = *(const LAS bf16x8*)(lds + HG_KH + r * HG_P + (16 * s + 8 * hh) * 2); at0 = MFMA32(kf, qf[s], at0); }
        if (tb == 1) {
#pragma unroll
            for (int s = 0; s < 8; ++s) { const bf16x8 kf = *(const LAS bf16x8*)(lds + HG_KH + (32 + r) * HG_P + (16 * s + 8 * hh) * 2); at1 = MFMA32(kf, qf[s], at1); }
#pragma unroll
            for (int j = 0; j < 16; ++j) if (crow(j, hh) > r) at1[j] = 0.f;
        } else {
#pragma unroll
            for (int j = 0; j < 16; ++j) if (crow(j, hh) > r) at0[j] = 0.f;
        }
        { const ldsp vtp = lds + HG_VT + (32 * vb + r) * HG_PT + 8 * hh;
#pragma unroll
          for (int s2 = 0; s2 < 2; ++s2) {
              const bf16x8 pf = pack_step(at0, s2);
              const s16x4 lo = *(const LAS s16x4*)(vtp + 32 * s2), hi = *(const LAS s16x4*)(vtp + 32 * s2 + 16);
              out = MFMA32(__builtin_shufflevector(lo, hi, 0, 1, 2, 3, 4, 5, 6, 7), pf, out);
          }
          if (tb == 1) {
#pragma unroll
              for (int s2 = 0; s2 < 2; ++s2) {
                  const bf16x8 pf = pack_step(at1, s2);
                  const s16x4 lo = *(const LAS s16x4*)(vtp + 64 + 32 * s2), hi = *(const LAS s16x4*)(vtp + 64 + 32 * s2 + 16);
                  out = MFMA32(__builtin_shufflevector(lo, hi, 0, 1, 2, 3, 4, 5, 6, 7), pf, out);
              }
          } }
#pragma unroll
        for (int s = 0; s < 8; ++s) { const bf16x8 sf = *(const LAS bf16x8*)(lds + HG_SS + (32 * vb + r) * HG_P + (16 * s + 8 * hh) * 2); out = MFMA32(sf, qf[s], out); }
        { float sq = 0.f;
#pragma unroll
          for (int j = 0; j < 16; ++j) sq += out[j] * out[j];
          sq += __shfl_xor(sq, 32);
          if (hh == 0) *(LAS float*)(lds + HG_SSQ + (vb * 64 + 32 * tb + r) * 4) = sq; }
        __syncthreads();
        { const int tl = 32 * tb + r;
          const float tot = (*(const LAS float*)(lds + HG_SSQ + tl * 4) + *(const LAS float*)(lds + HG_SSQ + (64 + tl) * 4)) + (*(const LAS float*)(lds + HG_SSQ + (128 + tl) * 4) + *(const LAS float*)(lds + HG_SSQ + (192 + tl) * 4));
          const float rs = rsqrtf(tot * (1.0f / 128.0f) + 1e-6f);
          const size_t row = row0 + tl;
#pragma unroll
          for (int g4 = 0; g4 < 4; ++g4) {
              const int v0 = 32 * vb + 8 * g4 + 4 * hh;
              const u32x2 gt = gtr[g4];
              const f32x4 gn = *(const f32x4*)(gnorm + v0);
              const float a0 = out[4 * g4] * rs * gn[0] * __uint_as_float(gt.x << 16), a1 = out[4 * g4 + 1] * rs * gn[1] * __uint_as_float(gt.x & 0xffff0000u);
              const float a2 = out[4 * g4 + 2] * rs * gn[2] * __uint_as_float(gt.y << 16), a3 = out[4 * g4 + 3] * rs * gn[3] * __uint_as_float(gt.y & 0xffff0000u);
              u32x2 wv; wv.x = cvtpk(a0, a1); wv.y = cvtpk(a2, a3);
              *(u32x2*)(MIX + row * DM + 512 + h * 128 + v0) = wv;
          } }
    }
    __syncthreads();
    }
#undef HG_LOAD
}

__device__ __forceinline__ void hgrn_scan(int bh, bf16_t* TS, const float* SC) {
    int tid = threadIdx.x; asm volatile("" : "+v"(tid));
    const int k8 = (tid & 15) * 8, v0 = tid >> 4;
    float S[4][8];
#pragma unroll
    for (int i = 0; i < 4; ++i)
#pragma unroll
        for (int j = 0; j < 8; ++j) S[i][j] = 0.f;
    bf16_t* base = TS + (size_t)bh * 64 * 16384 + (size_t)v0 * 128 + k8;
    const float* scb = SC + (size_t)bh * 64 * 256 + k8;
    u32x4 Tr[4][4]; f32x4 dlr[4][2], err[4][2];
#define HS_LOAD(d, c) do { _Pragma("unroll") for (int i_ = 0; i_ < 4; ++i_) Tr[d][i_] = *(const u32x4*)(base + (size_t)(c) * 16384 + i_ * 32 * 128); \
        dlr[d][0] = *(const f32x4*)(scb + (size_t)(c) * 256); dlr[d][1] = *(const f32x4*)(scb + (size_t)(c) * 256 + 4); \
        err[d][0] = *(const f32x4*)(scb + (size_t)(c) * 256 + 128); err[d][1] = *(const f32x4*)(scb + (size_t)(c) * 256 + 132); } while (0)
#pragma unroll
    for (int d = 0; d < 4; ++d) HS_LOAD(d, d);
#pragma unroll 1
    for (int c0 = 0; c0 < 64; c0 += 4) {
#pragma unroll
        for (int d = 0; d < 4; ++d) {
            const int c = c0 + d;
            float dl[8], er[8];
#pragma unroll
            for (int j = 0; j < 4; ++j) { dl[j] = dlr[d][0][j]; dl[4 + j] = dlr[d][1][j]; er[j] = err[d][0][j]; er[4 + j] = err[d][1][j]; }
#pragma unroll
            for (int i = 0; i < 4; ++i) {
                const u32x4 t = Tr[d][i];
                u32x4 o; o.x = cvtpk(S[i][0] * er[0], S[i][1] * er[1]); o.y = cvtpk(S[i][2] * er[2], S[i][3] * er[3]); o.z = cvtpk(S[i][4] * er[4], S[i][5] * er[5]); o.w = cvtpk(S[i][6] * er[6], S[i][7] * er[7]);
                S[i][0] = S[i][0] * dl[0] + __uint_as_float(t.x << 16); S[i][1] = S[i][1] * dl[1] + __uint_as_float(t.x & 0xffff0000u);
                S[i][2] = S[i][2] * dl[2] + __uint_as_float(t.y << 16); S[i][3] = S[i][3] * dl[3] + __uint_as_float(t.y & 0xffff0000u);
                S[i][4] = S[i][4] * dl[4] + __uint_as_float(t.z << 16); S[i][5] = S[i][5] * dl[5] + __uint_as_float(t.z & 0xffff0000u);
                S[i][6] = S[i][6] * dl[6] + __uint_as_float(t.w << 16); S[i][7] = S[i][7] * dl[7] + __uint_as_float(t.w & 0xffff0000u);
                *(u32x4*)(base + (size_t)c * 16384 + i * 32 * 128) = o;
            }
            if (c + 4 < 64) HS_LOAD(d, c + 4);
        }
    }
#undef HS_LOAD
}


#define XB_TMO      128
#define XB_XCNT(j)  (256  + 64 * (j))
#define XB_XSUB(j)  (1280 + 64 * (j))
#define XB_XGEN(j)  (2304 + 64 * (j))
#define XB_TOP      3328
#define XB_TOPGEN   3392
#define XCD_BAR_WORDS 3456
#define XB_SPIN_CAP (1u << 18)

__device__ __forceinline__ unsigned xb_ld(unsigned* p)              { return __hip_atomic_load(p, __ATOMIC_RELAXED, __HIP_MEMORY_SCOPE_AGENT); }
__device__ __forceinline__ unsigned xb_add(unsigned* p, unsigned v) { return __hip_atomic_fetch_add(p, v, __ATOMIC_RELAXED, __HIP_MEMORY_SCOPE_AGENT); }
__device__ __forceinline__ unsigned xb_xcc_id() { return (unsigned)__builtin_amdgcn_s_getreg((3 << 11) | 20) & 0xFu; }
#define XB_SPIN(cond, bar) do { unsigned _sp = 0; while (cond) { __builtin_amdgcn_s_sleep(1); \
    if ((++_sp & 255u) == 0u) { if (xb_ld(&(bar)[XB_TMO])) break; if (_sp > XB_SPIN_CAP) { atomicAdd(&(bar)[XB_TMO], 1u); break; } } } } while (0)

struct XcdBarrier {
    unsigned* bar; unsigned x;
    volatile LAS unsigned* st;
};

__device__ __forceinline__ XcdBarrier xcd_barrier_post(unsigned* bar, volatile LAS unsigned* st) {
    XcdBarrier b; b.bar = bar; b.x = xb_xcc_id(); b.st = st;
    if (threadIdx.x == 0) (void)xb_add(&bar[XB_XCNT(b.x)], 1u);
    return b;
}
__device__ __forceinline__ void xcd_barrier_complete(unsigned* bar, unsigned x, unsigned& nloc, unsigned& nx) {
    const unsigned G = gridDim.x * gridDim.y * gridDim.z;
    unsigned sum, cnt, mine, sp = 0u;
    for (;;) {
        sum = 0u; cnt = 0u; mine = 0u;
#pragma unroll
        for (unsigned j = 0; j < 16; ++j) { const unsigned c = xb_ld(&bar[XB_XCNT(j)]); sum += c; cnt += (c > 0u) ? 1u : 0u; mine = (j == x) ? c : mine; }
        if (sum == G) break;
        __builtin_amdgcn_s_sleep(1);
        if ((++sp & 255u) == 0u) { if (xb_ld(&bar[XB_TMO])) break; if (sp > XB_SPIN_CAP) { atomicAdd(&bar[XB_TMO], 1u); break; } }
    }
    nloc = mine > 0u ? mine : 1u; nx = cnt > 0u ? cnt : 1u;
}

__device__ __forceinline__ void xcd_barrier(const XcdBarrier& b) {
    asm volatile("s_waitcnt vmcnt(0)" ::: "memory");
    __syncthreads();
    if (threadIdx.x == 0) {
        unsigned* bar = b.bar;
        __builtin_amdgcn_s_waitcnt(0);
        unsigned nloc = b.st[0], nx = b.st[1];
        if (nloc == 0u) { xcd_barrier_complete(bar, b.x, nloc, nx); b.st[0] = nloc; b.st[1] = nx; }
        const unsigned old = xb_add(&bar[XB_XSUB(b.x)], 1u);
        const unsigned gen = old / nloc;
        if (old + 1u == (gen + 1u) * nloc) {
            __builtin_amdgcn_fence(__ATOMIC_RELEASE, "agent");
            asm volatile("s_waitcnt vmcnt(0)" ::: "memory");
            const unsigned og = xb_add(&bar[XB_TOP], 1u);
            const unsigned tg = og / nx;
            if (og + 1u == (tg + 1u) * nx) xb_add(&bar[XB_TOPGEN], 1u);
            else XB_SPIN(xb_ld(&bar[XB_TOPGEN]) == tg, bar);
            __builtin_amdgcn_fence(__ATOMIC_ACQUIRE, "agent");
            xb_add(&bar[XB_XGEN(b.x)], 1u);
            asm volatile("s_waitcnt vmcnt(0)" ::: "memory");
        } else {
            XB_SPIN(xb_ld(&bar[XB_XGEN(b.x)]) == gen, bar);
            __builtin_amdgcn_fence(__ATOMIC_ACQUIRE, "agent");
            asm volatile("s_waitcnt vmcnt(0)" ::: "memory");
        }
    }
    __syncthreads();
}

__device__ __forceinline__ void grid_seam_cg(cg::grid_group& grid) {
    asm volatile("s_waitcnt vmcnt(0) lgkmcnt(0)" ::: "memory");
    __syncthreads();
    if (threadIdx.x == 0) asm volatile("buffer_wbl2 sc1\n\ts_waitcnt vmcnt(0)" ::: "memory");
    grid.sync();
    asm volatile("buffer_inv sc1\n\ts_waitcnt vmcnt(0)" ::: "memory");
}
__global__ void __launch_bounds__(NTHR, 2) mega_fwd(Args args) {
    extern __shared__ __attribute__((aligned(16))) unsigned char lds_raw[];
    cg::grid_group grid = cg::this_grid();
    const ldsp lds = (ldsp)lds_raw;
    const int tid = threadIdx.x, lane = tid & 63, wave = __builtin_amdgcn_readfirstlane(tid >> 6);
    const int G = gridDim.x, bx = blockIdx.x;
    unsigned char* ws = args.ws;
    unsigned* ctl = (unsigned*)(ws + WS_CTL);
    float* ctlf = (float*)(ws + WS_CTL);
    unsigned long long* SS = (unsigned long long*)(ws + WS_SS);
    bf16_t* XB = (bf16_t*)(ws + WS_XB);
    bf16_t* Zb = (bf16_t*)(ws + WS_Z);
    _Float16* Gb = (_Float16*)(ws + WS_G);
    bf16_t* Ub = (bf16_t*)(ws + WS_U);
    bf16_t* MIXb = (bf16_t*)(ws + WS_MIX);
    const float* x_in = args.in[0];
    float* X = args.out;
    LAS int* const sh_idx = (LAS int*)(lds + LDS_BYTES - 16);
    if (tid < 8) *(LAS unsigned*)(lds + LDS_BYTES - 32 + 4 * tid) = 0u;
    __syncthreads();
    const XcdBarrier xbar = xcd_barrier_post(ctl + CW_BAR, (volatile LAS unsigned*)(lds + LDS_BYTES - 32));

    {
        const int gw = bx * NWAVES + wave, NGW = G * NWAVES;
        LAS float* scr = (LAS float*)(lds + wave * 16384);
        constexpr int I_TOT = DEPTH * ((DM / 64) * (INC / 32) + (DM / 64) * (DM / 32) + (DM / 64) * (FF / 32) + (FF / 64) * (DM / 32));
        { f32x4 wv[8], wn[8]; float gg[8], gn[8];
          P0Item cur = p0_decode(args, ws, gw < I_TOT ? gw : 0), nxt = cur;
          if (gw < I_TOT) p0_load(cur, lane, wv, gg);
#pragma unroll 1
          for (int it = gw; it < I_TOT; it += NGW) {
              const bool has = (it + NGW < I_TOT);
              if (has) { nxt = p0_decode(args, ws, it + NGW); p0_load(nxt, lane, wn, gn); }
              p0_store(cur, lane, scr, wv, gg);
              if (has) { cur = nxt;
#pragma unroll
                  for (int i = 0; i < 8; ++i) { wv[i] = wn[i]; gg[i] = gn[i]; } }
          } }
        { f32x4 v[4], vn[4];
          if (gw < M_TOK) { const f32x4* xr = (const f32x4*)(x_in + (size_t)gw * DM) + lane;
#pragma unroll
              for (int j = 0; j < 4; ++j) v[j] = xr[64 * j]; }
#pragma unroll 1
          for (int m = gw; m < M_TOK; m += NGW) {
              const bool has = (m + NGW < M_TOK);
              if (has) { const f32x4* xr = (const f32x4*)(x_in + (size_t)(m + NGW) * DM) + lane;
#pragma unroll
                  for (int j = 0; j < 4; ++j) vn[j] = xr[64 * j]; }
              float s2 = 0.f;
#pragma unroll
              for (int j = 0; j < 4; ++j) s2 += (v[j].x * v[j].x + v[j].y * v[j].y) + (v[j].z * v[j].z + v[j].w * v[j].w);
              s2 = wave_sum(s2);
              u32x2* o8 = (u32x2*)(XB + (size_t)m * DM) + lane;
#pragma unroll
              for (int j = 0; j < 4; ++j) { u32x2 wv2; wv2.x = cvtpk(v[j].x, v[j].y); wv2.y = cvtpk(v[j].z, v[j].w); o8[64 * j] = wv2; }
              if (lane == 0) SS[m] = (unsigned long long)(s2 * pg8::SS_FIX);
              if (has) {
#pragma unroll
                  for (int j = 0; j < 4; ++j) v[j] = vn[j]; }
          } }
        for (int i = bx * NTHR + tid; i < 8 * M_TOK; i += G * NTHR) SS[M_TOK + i] = 0ull;
        if (bx == 0) {
            { const float* lg = args.in[5]; const int c = tid;
              const float a0 = lg[c], a1 = lg[512 + c], a2 = lg[1024 + c], a3 = lg[1536 + c];
              const float mx = fmaxf(fmaxf(a0, a1), fmaxf(a2, a3));
              const float e0 = expf(a0 - mx), e1 = expf(a1 - mx), e2 = expf(a2 - mx), e3 = expf(a3 - mx);
              const float inv = 1.0f / ((e0 + e1) + (e2 + e3));
              ctlf[CW_LB + c] = 0.f; ctlf[CW_LB + 512 + c] = e1 * inv; ctlf[CW_LB + 1024 + c] = (e1 + e2) * inv; ctlf[CW_LB + 1536 + c] = (e1 + e2 + e3) * inv; }
            if (wave < DEPTH) {
                const float* lq = args.in[3] + wave * 256;
                const float p1 = wave_sum(lq[lane] * lq[64 + lane]), p2 = wave_sum(lq[128 + lane] * lq[192 + lane]);
                if (lane == 0) ctlf[CW_LAM + wave] = expf(p1) - expf(p2) + (0.8f - 0.6f * expf(-0.3f * (float)wave));
            }
        }
    }
    if (args.ws == nullptr) grid_seam_cg(grid);
    xcd_barrier(xbar);

#pragma unroll 1
    for (int step = 0; step < 7 * DEPTH; ++step) {
        const int l = step / 7, ph = step - 7 * l;
        unsigned char* wl = ws + WS_W + (size_t)l * W_LAYER;
        unsigned long long* ss1 = SS + (size_t)(2 * l) * M_TOK;
        unsigned long long* ss2 = SS + (size_t)(2 * l + 1) * M_TOK;
        unsigned long long* ss3 = SS + (size_t)(2 * l + 2) * M_TOK;
        bf16_t* TSb = (bf16_t*)args.out; float* SCb = (float*)(ws + WS_SC);
        const float* gnh = args.in[6] + l * 128;
#ifndef PROBE_REPEAT_PH
#define PROBE_REPEAT_PH -1
#endif
#ifndef PROBE_LITE
#define PROBE_LITE 0
#endif
#pragma unroll 1
        for (int rep = 0; rep < (ph == PROBE_REPEAT_PH ? 2 : 1); ++rep) {
        if (ph == 1) {
            hgrn_chunk<1>(lds, bx, G, Zb, Gb, TSb, SCb, MIXb, gnh);
        } else if (ph == 3) {
            hgrn_chunk<3>(lds, bx, G, Zb, Gb, TSb, SCb, MIXb, gnh, PROBE_LITE * rep);
        } else if (ph == 2) {
            const float lam = ctlf[CW_LAM + l];
            const float oscale = 1.0f - (0.8f - 0.6f * expf(-0.3f * (float)l));
            const float* relb = args.in[11];
            const float* gna = args.in[4] + l * 128;
            const int xcc = (int)(xb_xcc_id() & 7u);
            attn_bias_tables(lds, relb);
#pragma unroll 1
            for (int qi = 0; qi < 8; ++qi) {
                const int xq = (xcc + qi) & 7;
                unsigned* qctr = ctl + CW_QCTR + 64 * ((l + DEPTH * rep) * 8 + xq);
                for (;;) {
                    if (tid == 0) *sh_idx = (rep ? 4 : 0) + (int)__hip_atomic_fetch_add(qctr, 1u, __ATOMIC_RELAXED, __HIP_MEMORY_SCOPE_AGENT);
                    __syncthreads();
                    const int idx = *sh_idx;
                    __syncthreads();
                    if (idx >= 4 + 128) break;
#ifdef PROBE_SCAN_LAST
                    if (idx >= 128) hgrn_scan(4 * xq + idx - 128, TSb, SCb);
                    else { const int a = idx, pr = a >> 6,
#else
                    if (idx < 4) hgrn_scan(4 * xq + idx, TSb, SCb);
                    else { const int a = idx - 4, pr = a >> 6,
#endif
                           qb = 31 - ((a & 63) >> 1), bh = 4 * xq + 2 * pr + (a & 1);
#ifdef PROBE_ATT
                           if (rep) attn_unit<PROBE_ATT>(lds, bh >> 2, bh & 3, qb, Zb, MIXb, relb, gna, lam, oscale); else
#endif
                           attn_unit<0>(lds, bh >> 2, bh & 3, qb, Zb, MIXb, relb, gna, lam, oscale); }
                }
            }
        } else {
            pg8::Gemm g; pg8::EpiAny E{};
            if (ph == 0)      { g = pg8::Gemm{XB, (const bf16_t*)(wl + W_IN), M_TOK, INC, DM}; E.mode = 0; E.Z = Zb; E.G = Gb; E.ss = ss1; E.lb = ctlf + CW_LB + 512 * l; }
            else if (ph == 4) { g = pg8::Gemm{MIXb, (const bf16_t*)(wl + W_OUT), M_TOK, DM, DM}; E.mode = 1; E.ascale = 1.0f; E.xb = XB; E.ssn = ss2; }
            else if (ph == 5) { g = pg8::Gemm{XB, (const bf16_t*)(wl + W_UP), M_TOK, FF, DM}; E.mode = 2; E.Z = Ub; E.ss = ss2; }
            else              { g = pg8::Gemm{Ub, (const bf16_t*)(wl + W_DOWN), M_TOK, DM, FF, 1}; E.mode = 1; E.ascale = 1.0f; E.xb = XB; E.ssn = ss3; }
            pg8::StaticOrder S; S.init(M_TOK, g.N, G, bx, ph == 6);
            pg8::gemm_phase<pg8::EpiAny, pg8::StaticOrder, true, true>(lds, g, S, E);
        }
        xcd_barrier(xbar);
#ifdef PROBE_SEAM2
        xcd_barrier(xbar);
#endif
        }
    }
    {
        const int gw = bx * NWAVES + wave, NGW = G * NWAVES;
        const float* fg = args.in[12];
        const unsigned long long* ssf = SS + (size_t)8 * M_TOK;
        f32x4 gv[4];
#pragma unroll
        for (int j = 0; j < 4; ++j) gv[j] = ((const f32x4*)fg)[lane + 64 * j];
        for (int m = gw; m < M_TOK; m += NGW) {
            const u32x2* xr = (const u32x2*)(XB + (size_t)m * DM) + lane;
            f32x4* orow = (f32x4*)(X + (size_t)m * DM) + lane;
            const float rs = rsqrtf((float)ssf[m] * pg8::SS_INV + 1e-6f);
#pragma unroll
            for (int j = 0; j < 4; ++j) { const u32x2 xw = xr[64 * j];
                const f32x4 v = {__uint_as_float(xw.x << 16), __uint_as_float(xw.x & 0xffff0000u), __uint_as_float(xw.y << 16), __uint_as_float(xw.y & 0xffff0000u)};
                orow[64 * j] = v * rs * gv[j]; }
        }
    }
}

extern "C" void kernel_launch(void* const* d_in, const int* in_sizes, int n_in, void* d_out, int out_size, void* d_ws, size_t ws_size, hipStream_t stream) {
    static int grid = 0;
    if (grid == 0) {
        if (n_in != 13 || ws_size < WS_END) { fprintf(stderr, "kernel_launch: unexpected n_in %d / ws_size %zu (need %zu)\n", n_in, ws_size, (size_t)WS_END); grid = -1; return; }
        int dev = 0, cus = 0, per_cu = 0;
        hipGetDevice(&dev);
        hipDeviceGetAttribute(&cus, hipDeviceAttributeMultiprocessorCount, dev);
        if (hipFuncSetAttribute((const void*)mega_fwd, hipFuncAttributeMaxDynamicSharedMemorySize, LDS_BYTES) != hipSuccess) { fprintf(stderr, "kernel_launch: hipFuncSetAttribute failed\n"); grid = -1; return; }
        if (hipOccupancyMaxActiveBlocksPerMultiprocessor(&per_cu, (const void*)mega_fwd, NTHR, LDS_BYTES) != hipSuccess || per_cu < 1) { fprintf(stderr, "kernel_launch: occupancy query says %d\n", per_cu); per_cu = 1; }
        (void)hipGetLastError();
        grid = cus * 1;
    }
    if (grid < 0) return;
    if (hipMemsetAsync((char*)d_ws + WS_CTL, 0, CTL_ZERO_BYTES, stream) != hipSuccess) { fprintf(stderr, "kernel_launch: hipMemsetAsync failed\n"); return; }
    Args a{};
    for (int i = 0; i < 13; ++i) a.in[i] = (const float*)d_in[i];
    a.out = (float*)d_out; a.ws = (unsigned char*)d_ws;
    void* kargs[] = {&a};
    hipError_t e = hipLaunchCooperativeKernel((const void*)mega_fwd, dim3(grid), dim3(NTHR), kargs, LDS_BYTES, stream);
    if (e != hipSuccess) fprintf(stderr, "kernel_launch: cooperative launch failed: %s (grid %d)\n", hipGetErrorString(e), grid);
}
```

```cpp
#include <hip/hip_runtime.h>
#include <hip/hip_cooperative_groups.h>
#include <cstdio>
#include <cstdint>
namespace cg = cooperative_groups;
namespace pg8 {
#define PG8_LAS __attribute__((address_space(3)))
typedef unsigned short bf16_t;
typedef short bf16x8 __attribute__((ext_vector_type(8)));
typedef float f32x4 __attribute__((ext_vector_type(4)));
typedef unsigned u32x4 __attribute__((ext_vector_type(4)));
constexpr int BM = 256, BK = 64, HALF = 128, HTB = HALF * BK * 2  , STAGE_BYTES = 8 * HTB, NXCD = 8, WGM = 8;

__host__ __device__ __forceinline__ int lds_byte(int r, int c) { const int st = (r >> 4) * 2 + (c >> 5), rr = r & 15, cc = c & 31, ob = rr * 64 + cc * 2; return st * 1024 + (ob ^ (((ob >> 9) & 1) << 5)); }
__host__ __device__ __forceinline__ void stage_rc(int b, int& R, int& C) { const int st = b / 1024, sb = b % 1024, swz = sb ^ (((sb >> 9) & 1) << 5); R = (st >> 1) * 16 + swz / 64; C = (st & 1) * 32 + (swz % 64) / 2; }
__host__ __device__ __forceinline__ int perm32(int rho) { const int n = rho >> 4, i = rho & 15; return 8 * (i >> 2) + 4 * n + (i & 3); }

struct Unit { int pm, pn; };
struct Gemm { const bf16_t* A; const bf16_t* Bt; int M, N, K; int ablk; };

struct StaticOrder {
    int nM, nN, nwg, G, c, rev, pm0;
    __host__ __device__ void init(int M, int N, int G_, int c_, int rev_ = 0, int pm0_ = 0) { nM = M / BM; nN = N / BM; nwg = nM * nN; G = G_; c = c_; rev = (rev_ && nwg % G_ == 0) ? 1 : 0; pm0 = pm0_; }
    __host__ __device__ bool next(int i, Unit& u) const {
        if (rev && i >= nwg / G) return false;
        const long L = (long)(rev ? nwg / G - 1 - i : i) * G + c; if (L >= nwg) return false;
        int wgid = (int)L; { const int q = nwg / NXCD, r = nwg % NXCD, xcd = wgid % NXCD, off = wgid / NXCD; wgid = (xcd < r ? xcd * (q + 1) : r * (q + 1) + (xcd - r) * q) + off; }
        const int nig = WGM * nN, gid = wgid / nig, fm = gid * WGM, gsz = (nM - fm) < WGM ? (nM - fm) : WGM;
        u.pm = pm0 + fm + ((wgid % nig) % gsz); u.pn = (wgid % nig) / gsz; return true;
    }
    __device__ __forceinline__ void a_ready(const Unit&) const {}
    __device__ __forceinline__ void done(const Unit&) const {}
};

__device__ __forceinline__ unsigned cvt_pk_bf16(float lo, float hi) { unsigned r; asm volatile("v_cvt_pk_bf16_f32 %0, %1, %2" : "=v"(r) : "v"(lo), "v"(hi)); return r; }
typedef float f32x2 __attribute__((ext_vector_type(2)));
typedef unsigned u32x2 __attribute__((ext_vector_type(2)));
typedef _Float16 h16x8 __attribute__((ext_vector_type(8)));
__device__ __forceinline__ float silu_f(float x) { return x * __builtin_amdgcn_rcpf(1.0f + __expf(-x)); }
constexpr float SS_FIX = 1048576.0f, SS_INV = 1.0f / (1024.0f * 1048576.0f);
constexpr float QSCALE = 0.125f * 1.4426950408889634f;

struct EpiAny {
    static constexpr bool PERM = true, AFTER_DRAIN = false;
    int mode;
    bf16_t* Z; _Float16* G; const unsigned long long* ss; const float* lb;
    bf16_t* xb; unsigned long long* ssn; float ascale;
    __device__ __forceinline__ void operator()(const f32x4 (&acc)[2][2][4][2], const Unit& u, int wr, int wc, int fr, int fq) const {
        if (mode == 0) epi_in(acc, u, wr, wc, fr, fq); else if (mode == 1) epi_res(acc, u, wr, wc, fr, fq); else epi_up(acc, u, wr, wc, fr, fq);
    }
    __device__ __forceinline__ void epi_in(const f32x4 (&acc)[2][2][4][2], const Unit& u, int wr, int wc, int fr, int fq) const {
        const int row0 = u.pm * BM + wr * 64 + fr;
        const int grp = u.pn >> 1;
        const int cin = wc * 32 + 8 * fq;
        const int zc0 = (grp < 4 ? u.pn : u.pn - 2) * BM + cin;
        const int gc0 = (u.pn - 8) * BM + cin;
#pragma unroll
        for (int ai = 0; ai < 2; ++ai)
#pragma unroll
            for (int m = 0; m < 4; ++m) {
                const int row = row0 + ai * HALF + m * 16;
                const float rs = rsqrtf((float)ss[row] * SS_INV + 1e-6f);
#pragma unroll
                for (int bj = 0; bj < 2; ++bj) {
                    f32x4 v0 = acc[ai][bj][m][0] * rs, v1 = acc[ai][bj][m][1] * rs;
                    if (grp == 4) {
                        const int gc = gc0 + bj * HALF;
                        const f32x4 l0 = *(const f32x4*)(lb + gc), l1 = *(const f32x4*)(lb + gc + 4);
                        f32x4 o0, o1;
#pragma unroll
                        for (int j = 0; j < 4; ++j) {
                            o0[j] = __logf(l0[j] + (1.0f - l0[j]) * __builtin_amdgcn_rcpf(1.0f + __expf(-v0[j])));
                            o1[j] = __logf(l1[j] + (1.0f - l1[j]) * __builtin_amdgcn_rcpf(1.0f + __expf(-v1[j])));
                        }
                        h16x8 hv;
#pragma unroll
                        for (int j = 0; j < 4; ++j) { hv[j] = (_Float16)o0[j]; hv[4 + j] = (_Float16)o1[j]; }
                        *(h16x8*)(G + (size_t)row * 512 + gc) = hv;
                    } else {
                        if (grp == 0) { v0 = v0 * QSCALE; v1 = v1 * QSCALE; }
                        else if (grp == 3 || grp == 6) {
#pragma unroll
                            for (int j = 0; j < 4; ++j) { v0[j] = silu_f(v0[j]); v1[j] = silu_f(v1[j]); }
                        }
                        u32x4 w; w.x = cvt_pk_bf16(v0[0], v0[1]); w.y = cvt_pk_bf16(v0[2], v0[3]); w.z = cvt_pk_bf16(v1[0], v1[1]); w.w = cvt_pk_bf16(v1[2], v1[3]);
                        *(u32x4*)(Z + (size_t)row * 3072 + zc0 + bj * HALF) = w;
                    }
                }
            }
    }

    __device__ __forceinline__ void epi_res(const f32x4 (&acc)[2][2][4][2], const Unit& u, int wr, int wc, int fr, int fq) const {
        const int row0 = u.pm * BM + wr * 64 + fr;
        const int col0 = u.pn * BM + wc * 32 + 8 * fq;
#pragma unroll
        for (int ai = 0; ai < 2; ++ai) {
            u32x4 xo[4][2];
#pragma unroll
            for (int m = 0; m < 4; ++m)
#pragma unroll
                for (int bj = 0; bj < 2; ++bj) xo[m][bj] = *(const u32x4*)(xb + (size_t)(row0 + ai * HALF + m * 16) * 1024 + col0 + bj * HALF);
#pragma unroll
            for (int m = 0; m < 4; ++m) {
                const int row = row0 + ai * HALF + m * 16;
                float sq = 0.f;
#pragma unroll
                for (int bj = 0; bj < 2; ++bj) {
                    const u32x4 xw = xo[m][bj];
                    const f32x4 x0 = {__uint_as_float(xw.x << 16), __uint_as_float(xw.x & 0xffff0000u), __uint_as_float(xw.y << 16), __uint_as_float(xw.y & 0xffff0000u)};
                    const f32x4 x1 = {__uint_as_float(xw.z << 16), __uint_as_float(xw.z & 0xffff0000u), __uint_as_float(xw.w << 16), __uint_as_float(xw.w & 0xffff0000u)};
                    const f32x4 n0 = x0 + acc[ai][bj][m][0] * ascale, n1 = x1 + acc[ai][bj][m][1] * ascale;
                    u32x4 w; w.x = cvt_pk_bf16(n0[0], n0[1]); w.y = cvt_pk_bf16(n0[2], n0[3]); w.z = cvt_pk_bf16(n1[0], n1[1]); w.w = cvt_pk_bf16(n1[2], n1[3]);
                    *(u32x4*)(xb + (size_t)row * 1024 + col0 + bj * HALF) = w;
                    sq += ((n0[0] * n0[0] + n0[1] * n0[1]) + (n0[2] * n0[2] + n0[3] * n0[3])) + ((n1[0] * n1[0] + n1[1] * n1[1]) + (n1[2] * n1[2] + n1[3] * n1[3]));
                }
                sq += __shfl_xor(sq, 16); sq += __shfl_xor(sq, 32);
                if (fq == 0) __hip_atomic_fetch_add(ssn + row, (unsigned long long)(sq * SS_FIX), __ATOMIC_RELAXED, __HIP_MEMORY_SCOPE_AGENT);
            }
        }
    }

    __device__ __forceinline__ void epi_up(const f32x4 (&acc)[2][2][4][2], const Unit& u, int wr, int wc, int fr, int fq) const {
        const int row0 = u.pm * BM + wr * 64 + fr;
        const int col0 = u.pn * BM + wc * 32 + 8 * fq;
#pragma unroll
        for (int ai = 0; ai < 2; ++ai)
#pragma unroll
            for (int m = 0; m < 4; ++m) {
                const int row = row0 + ai * HALF + m * 16;
                const float rs = rsqrtf((float)ss[row] * SS_INV + 1e-6f);
#pragma unroll
                for (int bj = 0; bj < 2; ++bj) {
                    f32x4 v0 = acc[ai][bj][m][0] * rs, v1 = acc[ai][bj][m][1] * rs;
#pragma unroll
                    for (int j = 0; j < 4; ++j) { const float a = fmaxf(v0[j], 0.f), b = fmaxf(v1[j], 0.f); v0[j] = a * a; v1[j] = b * b; }
                    u32x4 w; w.x = cvt_pk_bf16(v0[0], v0[1]); w.y = cvt_pk_bf16(v0[2], v0[3]); w.z = cvt_pk_bf16(v1[0], v1[1]); w.w = cvt_pk_bf16(v1[2], v1[3]);
                    { const int col = col0 + bj * HALF;
                      *(u32x4*)(Z + ((size_t)((row >> 8) * 64 + (col >> 6)) * 256 + (row & 255)) * 64 + (col & 63)) = w; }
                }
            }
    }
};

template <class Epi, class Sched, bool ALIGN_EPI = false, bool SP2 = false>
__device__ __forceinline__ void gemm_phase(PG8_LAS unsigned char* lds, const Gemm g, const Sched& S, const Epi& E) {
    const int tid = threadIdx.x, wid = __builtin_amdgcn_readfirstlane(tid >> 6), lane = tid & 63, wr = wid >> 2, wc = wid & 3, fr = lane & 15, fq = lane >> 4;
    const int K = g.K, nt = K / BK;
    const int ldA = g.ablk ? BK : K;
    unsigned voffA[2], voffB[2];
#pragma unroll
    for (int i = 0; i < 2; ++i) { int R, C; stage_rc(tid * 16 + i * 8192, R, C); const int Rb = Epi::PERM ? ((R & ~31) + perm32(R & 31)) : R;
        voffA[i] = (unsigned)(R * ldA + C) * 2u; voffB[i] = (unsigned)(Rb * K + C) * 2u; }
    const size_t kstep = (size_t)(BK * 2);
    const size_t hstep = (size_t)HALF * K * 2;
    const size_t tstep = 2 * hstep;
    const size_t kstepA = g.ablk ? (size_t)BM * BK * 2 : kstep, hstepA = g.ablk ? (size_t)HALF * BK * 2 : hstep, tstepA = g.ablk ? (size_t)(K / BK) * BM * BK * 2 : tstep;
    const unsigned ldsw = (unsigned)wid * 1024u;
    const int aoff = lds_byte(wr * 64 + fr, fq * 8), boff = lds_byte(wc * 32 + fr, fq * 8);
#define PG8_SA(b, h) (((b) * 2 + (h)) * HTB)
#define PG8_SB(b, h) ((4 + (b) * 2 + (h)) * HTB)
#define PG8_STAGE(bufoff, gbase, voff) do { _Pragma("unroll") for (int _i = 0; _i < 2; ++_i) \
        __builtin_amdgcn_global_load_lds((const unsigned*)((const char*)(gbase) + (voff)[_i]), (PG8_LAS unsigned*)(lds + (bufoff) + ldsw + _i * 8192), 16, 0, 0); } while (0)
#define PG8_LDA(dst, b, h) do { _Pragma("unroll") for (int m = 0; m < 4; ++m) _Pragma("unroll") for (int k = 0; k < 2; ++k) dst[m][k] = *(const PG8_LAS bf16x8*)(lds + PG8_SA(b, h) + aoff + m * 2048 + k * 1024); } while (0)
#define PG8_LDB(dst, b, h) do { _Pragma("unroll") for (int n = 0; n < 2; ++n) _Pragma("unroll") for (int k = 0; k < 2; ++k) dst[n][k] = *(const PG8_LAS bf16x8*)(lds + PG8_SB(b, h) + boff + n * 2048 + k * 1024); } while (0)
#define PG8_MMA(ai, bj, At, Bt) do { __builtin_amdgcn_s_setprio(1); _Pragma("unroll") for (int m = 0; m < 4; ++m) _Pragma("unroll") for (int n = 0; n < 2; ++n) _Pragma("unroll") for (int k = 0; k < 2; ++k) \
        acc[ai][bj][m][n] = __builtin_amdgcn_mfma_f32_16x16x32_bf16(Bt[n][k], At[m][k], acc[ai][bj][m][n], 0, 0, 0); __builtin_amdgcn_s_setprio(0); } while (0)
#define PG8_WAIT_V(n) asm volatile("s_waitcnt vmcnt(" #n ")" ::: "memory")
#define PG8_WAIT_L(n) asm volatile("s_waitcnt lgkmcnt(" #n ")" ::: "memory")
#define PG8_BAR __builtin_amdgcn_s_barrier()
#define PG8_SCHED __builtin_amdgcn_sched_barrier(0)
    Unit cur, nxt; int ui = 0;
    if (!S.next(0, cur)) return;
    f32x4 acc[2][2][4][2];
#pragma unroll
    for (int a = 0; a < 2; ++a)
#pragma unroll
        for (int b = 0; b < 2; ++b)
#pragma unroll
            for (int m = 0; m < 4; ++m)
#pragma unroll
                for (int n = 0; n < 2; ++n) acc[a][b][m][n] = (f32x4){0.f, 0.f, 0.f, 0.f};
    bf16x8 At[4][2], B0[2][2], B1[2][2];
    const char* cA = (const char*)g.A + (size_t)cur.pm * tstepA; const char* cB = (const char*)g.Bt + (size_t)cur.pn * tstep;
    S.a_ready(cur);
    if constexpr (SP2) {
        PG8_STAGE(PG8_SB(0, 0), cB, voffB); PG8_STAGE(PG8_SB(0, 1), cB + hstep, voffB); PG8_STAGE(PG8_SA(0, 0), cA, voffA); PG8_STAGE(PG8_SA(0, 1), cA + hstepA, voffA);
        if (wr == 1) PG8_BAR;
        PG8_WAIT_V(2); PG8_BAR;
        PG8_STAGE(PG8_SB(1, 0), cB + kstep, voffB); PG8_STAGE(PG8_SA(1, 0), cA + kstepA, voffA); PG8_STAGE(PG8_SB(1, 1), cB + hstep + kstep, voffB);
        PG8_WAIT_V(6); PG8_BAR;
    } else {
        PG8_STAGE(PG8_SB(0, 0), cB, voffB); PG8_STAGE(PG8_SA(0, 0), cA, voffA); PG8_STAGE(PG8_SB(0, 1), cB + hstep, voffB); PG8_STAGE(PG8_SA(0, 1), cA + hstepA, voffA);
        if (wr == 1) PG8_BAR;
        PG8_WAIT_V(4); PG8_BAR;
        PG8_STAGE(PG8_SB(1, 0), cB + kstep, voffB); PG8_STAGE(PG8_SA(1, 0), cA + kstepA, voffA); PG8_STAGE(PG8_SB(1, 1), cB + hstep + kstep, voffB);
        PG8_WAIT_V(6); PG8_BAR;
    }
    for (;;) {
        const bool has_next = S.next(ui + 1, nxt);
        const char* nA = has_next ? (const char*)g.A + (size_t)nxt.pm * tstepA : cA; const char* nB = has_next ? (const char*)g.Bt + (size_t)nxt.pn * tstep : cB;
        for (int t = 0; t < nt; t += 2) {
            const bool last = (t == nt - 2);
            const char* a1 = cA + (size_t)(t + 1) * kstepA;
            const char* a2 = last ? nA : cA + (size_t)(t + 2) * kstepA; const char* b2 = last ? nB : cB + (size_t)(t + 2) * kstep;
            const char* a3 = a2 + kstepA; const char* b3 = b2 + kstep;
            if (last && has_next) S.a_ready(nxt);
            if constexpr (SP2) {
            PG8_LDB(B0, 0, 0); PG8_LDB(B1, 0, 1); PG8_SCHED; PG8_LDA(At, 0, 0); PG8_STAGE(PG8_SA(1, 1), a1 + hstepA, voffA);
            PG8_WAIT_V(8); PG8_WAIT_L(0); PG8_BAR; PG8_MMA(0, 0, At, B0); PG8_MMA(0, 1, At, B1); PG8_BAR; PG8_SCHED;
            PG8_LDA(At, 0, 1); PG8_STAGE(PG8_SB(0, 0), b2, voffB); PG8_STAGE(PG8_SB(0, 1), b2 + hstep, voffB); PG8_STAGE(PG8_SA(0, 0), a2, voffA);
            PG8_WAIT_V(8); PG8_WAIT_L(0); PG8_BAR; PG8_MMA(1, 0, At, B0); PG8_MMA(1, 1, At, B1); PG8_BAR; PG8_SCHED;
            PG8_LDB(B0, 1, 0); PG8_LDB(B1, 1, 1); PG8_SCHED; PG8_LDA(At, 1, 0); PG8_STAGE(PG8_SA(0, 1), a2 + hstepA, voffA);
            PG8_WAIT_V(8); PG8_WAIT_L(0); PG8_BAR; PG8_MMA(0, 0, At, B0); PG8_MMA(0, 1, At, B1); PG8_BAR; PG8_SCHED;
            PG8_LDA(At, 1, 1); PG8_STAGE(PG8_SB(1, 0), b3, voffB); PG8_STAGE(PG8_SB(1, 1), b3 + hstep, voffB); PG8_STAGE(PG8_SA(1, 0), a3, voffA);
            PG8_WAIT_V(8); PG8_WAIT_L(0); PG8_BAR; PG8_MMA(1, 0, At, B0); PG8_MMA(1, 1, At, B1); PG8_BAR; PG8_SCHED;
            } else {
            PG8_LDB(B0, 0, 0); PG8_SCHED; PG8_LDA(At, 0, 0); PG8_STAGE(PG8_SA(1, 1), a1 + hstepA, voffA);
            PG8_WAIT_L(8); PG8_BAR; PG8_WAIT_L(0); PG8_MMA(0, 0, At, B0); PG8_BAR; PG8_SCHED;
            PG8_LDB(B1, 0, 1); PG8_STAGE(PG8_SB(0, 0), b2, voffB);
            PG8_BAR; PG8_WAIT_L(0); PG8_MMA(0, 1, At, B1); PG8_BAR;
            PG8_LDA(At, 0, 1); PG8_STAGE(PG8_SA(0, 0), a2, voffA);
            PG8_BAR; PG8_WAIT_L(0); PG8_MMA(1, 0, At, B0); PG8_BAR; PG8_SCHED;
            PG8_STAGE(PG8_SB(0, 1), b2 + hstep, voffB);
            PG8_WAIT_V(6); PG8_BAR; PG8_MMA(1, 1, At, B1); PG8_BAR;
            PG8_LDB(B0, 1, 0); PG8_SCHED; PG8_LDA(At, 1, 0); PG8_STAGE(PG8_SA(0, 1), a2 + hstepA, voffA);
            PG8_WAIT_L(8); PG8_BAR; PG8_WAIT_L(0); PG8_MMA(0, 0, At, B0); PG8_BAR; PG8_SCHED;
            PG8_LDB(B1, 1, 1); PG8_STAGE(PG8_SB(1, 0), b3, voffB);
            PG8_BAR; PG8_WAIT_L(0); PG8_MMA(0, 1, At, B1); PG8_BAR;
            PG8_LDA(At, 1, 1); PG8_STAGE(PG8_SA(1, 0), a3, voffA);
            PG8_BAR; PG8_WAIT_L(0); PG8_MMA(1, 0, At, B0); PG8_BAR; PG8_SCHED;
            PG8_STAGE(PG8_SB(1, 1), b3 + hstep, voffB);
            PG8_WAIT_V(6); PG8_BAR; PG8_MMA(1, 1, At, B1); PG8_BAR;
            }
        }
        if constexpr (ALIGN_EPI) { if (wr == 0) PG8_BAR; }
        if constexpr (!Epi::AFTER_DRAIN) { E(acc, cur, wr, wc, fr, fq); S.done(cur); }
        if (!has_next) break;
#pragma unroll
        for (int a = 0; a < 2; ++a)
#pragma unroll
            for (int b = 0; b < 2; ++b)
#pragma unroll
                for (int m = 0; m < 4; ++m)
#pragma unroll
                    for (int n = 0; n < 2; ++n) acc[a][b][m][n] = (f32x4){0.f, 0.f, 0.f, 0.f};
        cur = nxt; cA = nA; cB = nB; ++ui;
        if constexpr (ALIGN_EPI) { if (wr == 1) PG8_BAR; }
    }
    PG8_WAIT_V(0);
    if constexpr (!ALIGN_EPI) { if (wr == 0) PG8_BAR; }
    PG8_BAR;
    if constexpr (Epi::AFTER_DRAIN) { E.fused(acc, cur, wr, wc, fr, fq, lds, wid, lane); S.done(cur); }
#undef PG8_SA
#undef PG8_SB
#undef PG8_STAGE
#undef PG8_LDA
#undef PG8_LDB
#undef PG8_MMA
#undef PG8_WAIT_V
#undef PG8_WAIT_L
#undef PG8_BAR
#undef PG8_SCHED
}
}
#define LAS __attribute__((address_space(3)))
typedef LAS unsigned char* ldsp;
typedef unsigned short bf16_t;
typedef short bf16x8 __attribute__((ext_vector_type(8)));
typedef short s16x4 __attribute__((ext_vector_type(4)));
typedef float f32x4 __attribute__((ext_vector_type(4)));
typedef float f32x16 __attribute__((ext_vector_type(16)));
typedef unsigned u32x4 __attribute__((ext_vector_type(4)));
typedef unsigned u32x2 __attribute__((ext_vector_type(2)));
typedef float f32x2_t __attribute__((ext_vector_type(2)));
typedef __bf16 bf16x2_t __attribute__((ext_vector_type(2)));

constexpr int M_TOK = 32768, SEQL = 4096, DM = 1024, INC = 3584, FF = 4096, ZP = 3072, DEPTH = 4;
constexpr int NWAVES = 8, NTHR = 512;
constexpr size_t MiB = 1u << 20;
constexpr size_t WS_CTL = 0;
constexpr size_t WS_SS = 1 * MiB;
constexpr size_t WS_W = 4 * MiB;
constexpr size_t W_LAYER = 25 * MiB, W_IN = 0, W_OUT = 7 * MiB, W_UP = 9 * MiB, W_DOWN = 17 * MiB;
constexpr size_t WS_XB = 104 * MiB;
constexpr size_t WS_Z = 168 * MiB;
constexpr size_t WS_G = 360 * MiB;
constexpr size_t WS_U = 168 * MiB;
constexpr size_t WS_MIX = 424 * MiB;
constexpr size_t WS_SC = 488 * MiB;
constexpr size_t WS_END = 490 * MiB;
constexpr int CW_QCTR = 8192;
constexpr int CW_LAM = 1024;
constexpr int CW_LB = 2048;
constexpr int CW_BAR = 4096;
constexpr size_t CTL_ZERO_BYTES = 65536;
constexpr int LDS_BYTES = 147456;
constexpr float LOG2E = 1.4426950408889634f;

__device__ __forceinline__ unsigned cvtpk(float lo, float hi) { f32x2_t v = {lo, hi}; bf16x2_t b = __builtin_convertvector(v, bf16x2_t); return __builtin_bit_cast(unsigned, b); }
__device__ __forceinline__ float bf2f(unsigned short u) { return __uint_as_float((unsigned)u << 16); }
__device__ __forceinline__ int crow(int reg, int h) { return (reg & 3) + 8 * (reg >> 2) + 4 * h; }
__device__ __forceinline__ float wave_sum(float v) {
#pragma unroll
    for (int o = 1; o < 64; o <<= 1) v += __shfl_xor(v, o);
    return v;
}
#define MFMA32(a, b, c) __builtin_amdgcn_mfma_f32_32x32x16_bf16((a), (b), (c), 0, 0, 0)
__device__ __forceinline__ bf16x8 pack_step(const f32x16& x, int s) {
    u32x4 p; p.x = cvtpk(x[8 * s], x[8 * s + 1]); p.y = cvtpk(x[8 * s + 2], x[8 * s + 3]); p.z = cvtpk(x[8 * s + 4], x[8 * s + 5]); p.w = cvtpk(x[8 * s + 6], x[8 * s + 7]);
    return __builtin_bit_cast(bf16x8, p);
}
typedef short v4i16_t __attribute__((ext_vector_type(4)));
__device__ __forceinline__ s16x4 vtr(ldsp p) { return __builtin_bit_cast(s16x4, __builtin_amdgcn_ds_read_tr16_b64_v4i16((LAS v4i16_t*)p)); }

struct P0Item { const float* W; const float* gk; bf16_t* WT; int K, N, k0, n0; };
__device__ __forceinline__ void p0_load(const P0Item& d, int lane, f32x4 (&wv)[8], float (&gg)[8]) {
    const int kr = lane >> 3, nq = (lane & 7) * 4;
#pragma unroll
    for (int i = 0; i < 8; ++i) { const int kk = 8 * i + kr; wv[i] = __builtin_nontemporal_load((const f32x4*)(d.W + (size_t)(d.k0 + kk) * d.N + d.n0 + nq));     gg[i] = d.gk ? d.gk[d.k0 + kk] : 1.0f; }
}
__device__ __forceinline__ void p0_store(const P0Item& d, int lane, LAS float* scr, const f32x4 (&wv)[8], const float (&gg)[8]) {
    const int kr = lane >> 3, nq = (lane & 7) * 4;
#pragma unroll
    for (int i = 0; i < 8; ++i) { const int kk = 8 * i + kr;
#pragma unroll
        for (int j = 0; j < 4; ++j) scr[kk * 33 + nq + j] = wv[i][j] * gg[i]; }
    asm volatile("s_waitcnt lgkmcnt(0)" ::: "memory");
    const int c = lane & 7;
#pragma unroll
    for (int j = 0; j < 4; ++j) { const int n = (lane >> 3) + 8 * j; const LAS float* sp = scr + (8 * c) * 33 + n;
        u32x4 o; o.x = cvtpk(sp[0 * 33], sp[1 * 33]); o.y = cvtpk(sp[2 * 33], sp[3 * 33]); o.z = cvtpk(sp[4 * 33], sp[5 * 33]); o.w = cvtpk(sp[6 * 33], sp[7 * 33]);
        *(u32x4*)(d.WT + (size_t)(d.n0 + n) * d.K + d.k0 + 8 * c) = o; }
    asm volatile("s_waitcnt lgkmcnt(0)" ::: "memory");
}

struct Args { const float* in[13]; float* out; unsigned char* ws; };
__device__ __forceinline__ P0Item p0_decode(const Args& args, unsigned char* ws, int it) {
    constexpr int I_IN = (DM / 64) * (INC / 32), I_OUT = (DM / 64) * (DM / 32), I_UP = (DM / 64) * (FF / 32), I_DN = (FF / 64) * (DM / 32), I_L = I_IN + I_OUT + I_UP + I_DN;
    const int l = it / I_L; int rr = it % I_L;
    unsigned char* wl = ws + WS_W + (size_t)l * W_LAYER;
    P0Item d;
    if (rr < I_IN) { d.W = args.in[2] + (size_t)l * DM * INC; d.gk = args.in[1] + l * DM; d.WT = (bf16_t*)(wl + W_IN); d.K = DM; d.N = INC; }
    else if ((rr -= I_IN) < I_OUT) { d.W = args.in[7] + (size_t)l * DM * DM; d.gk = nullptr; d.WT = (bf16_t*)(wl + W_OUT); d.K = DM; d.N = DM; }
    else if ((rr -= I_OUT) < I_UP) { d.W = args.in[9] + (size_t)l * DM * FF; d.gk = args.in[8] + l * DM; d.WT = (bf16_t*)(wl + W_UP); d.K = DM; d.N = FF; }
    else { rr -= I_UP; d.W = args.in[10] + (size_t)l * FF * DM; d.gk = nullptr; d.WT = (bf16_t*)(wl + W_DOWN); d.K = FF; d.N = DM; }
    const int nblk = d.N / 32; d.k0 = 64 * (rr / nblk); d.n0 = 32 * (rr % nblk);
    return d;
}


constexpr int AT_KP = 272, AT_VP = 320, AT_KB = 64 * AT_KP, AT_VB = 64 * AT_VP;
constexpr int AT_K0 = 0, AT_V0 = 2 * AT_KB, AT_BIAS = AT_V0 + 2 * AT_VB, AT_EX = 0;
static_assert(AT_BIAS >= 65536 && AT_BIAS + 4096 <= LDS_BYTES - 32, "attention LDS map");
__device__ __forceinline__ void attn_bias_tables(ldsp lds, const float* relb) {
    for (int e = threadIdx.x; e < 1024; e += NTHR) {
        const int h = e >> 8, rel = (e & 255) - 192, n = rel < 0 ? -rel : rel;
        int bk = rel > 0 ? 16 : 0;
        if (n < 8) bk += n;
        else { int lg = 8 + (int)(2.0f * __log2f((float)n * 0.125f) + 1e-4f); bk += lg < 15 ? lg : 15; }
        *(LAS float*)(lds + AT_BIAS + 4 * e) = (relb[bk * 4 + h] - relb[15 * 4 + h]) * LOG2E;
    }
}

template <int PB>
__device__ __forceinline__ void attn_unit(ldsp lds, int b, int h, int qb, const bf16_t* Z, bf16_t* MIX, const float* relb, const float* gnorm, float lam, float oscale) {
    int tid = threadIdx.x; asm volatile("" : "+v"(tid));
    const int lane = tid & 63, w = __builtin_amdgcn_readfirstlane(tid >> 6), r = lane & 31, hh = lane >> 5, i16 = lane & 15;
    const int wq = w & 3, map = w >> 2;
    const int rowbase = b * SEQL, q0 = qb * 128, qw = q0 + 32 * wq, ntiles = 2 * qb + 2, my_last = qw >> 6;
    bf16x8 qf[4];
    { const bf16_t* qp = Z + (size_t)(rowbase + qw + r) * ZP + h * 128 + map * 64 + 8 * hh;
#pragma unroll
      for (int d0 = 0; d0 < 4; ++d0) qf[d0] = *(const bf16x8*)(qp + 16 * d0); }
    const int srow0 = tid >> 4, scc = tid & 15;
    const bf16_t* kg = Z + (size_t)rowbase * ZP + 512 + h * 128 + scc * 8;
    const bf16_t* vg = Z + (size_t)rowbase * ZP + 1024 + h * 128 + scc * 8;
    u32x4 kr[2], vr[2];
#define AT_LOAD(kt) do { _Pragma("unroll") for (int i_ = 0; i_ < 2; ++i_) { const size_t ro_ = (size_t)((kt) * 64 + srow0 + 32 * i_) * ZP; kr[i_] = *(const u32x4*)(kg + ro_); vr[i_] = *(const u32x4*)(vg + ro_); } } while (0)
#define AT_STORE(buf) do { _Pragma("unroll") for (int i_ = 0; i_ < 2; ++i_) { const int row_ = srow0 + 32 * i_; \
        *(LAS u32x4*)(lds + AT_K0 + (buf) * AT_KB + row_ * AT_KP + scc * 16) = kr[i_]; *(LAS u32x4*)(lds + AT_V0 + (buf) * AT_VB + row_ * AT_VP + scc * 16) = vr[i_]; } } while (0)
    AT_LOAD(0); AT_STORE(0);
    __syncthreads();
    float mrun = 0.f, lrun = 0.f;
    f32x16 o[4], negm;
#pragma unroll
    for (int j = 0; j < 16; ++j) negm[j] = 0.f;
#pragma unroll
    for (int i = 0; i < 4; ++i)
#pragma unroll
        for (int j = 0; j < 16; ++j) o[i][j] = 0.f;
    for (int kt = 0; kt < ntiles; ++kt) {
        const bool more = (kt + 1 < ntiles);
        if (more && !(PB & 8)) AT_LOAD(kt + 1);
        if (kt <= my_last) {
            const ldsp Kb = lds + AT_K0 + (kt & 1) * AT_KB + r * AT_KP + (map * 64 + 8 * hh) * 2;
            const ldsp Vb = lds + AT_V0 + (kt & 1) * AT_VB + (4 * hh + (i16 >> 2)) * AT_VP + (16 * ((lane >> 4) & 1) + 4 * (i16 & 3)) * 2;
            f32x16 s0, s1;
#pragma unroll
            for (int d0 = 0; d0 < 4; ++d0) {
                const bf16x8 k0f = *(const LAS bf16x8*)(Kb + d0 * 32), k1f = *(const LAS bf16x8*)(Kb + 32 * AT_KP + d0 * 32);
                if (d0 == 0) { s0 = MFMA32(k0f, qf[0], negm); s1 = MFMA32(k1f, qf[0], negm); }
                else { s0 = MFMA32(k0f, qf[d0], s0); s1 = MFMA32(k1f, qf[d0], s1); }
            }
            if (64 * kt + 153 >= qw) {
                const int base = 64 * kt - (qw + r) + 192 + 4 * hh;
#pragma unroll
                for (int j = 0; j < 16; ++j) { int i0 = base + (j & 3) + 8 * (j >> 2); int i1 = i0 + 32; i0 = i0 < 0 ? 0 : i0; i1 = i1 < 0 ? 0 : i1;
                    s0[j] += *(const LAS float*)(lds + AT_BIAS + h * 1024 + 4 * i0); s1[j] += *(const LAS float*)(lds + AT_BIAS + h * 1024 + 4 * i1); }
            }
            if (!(PB & 4)) {
            float tmax = fmaxf(s0[0], s1[0]);
#pragma unroll
            for (int j = 1; j < 16; ++j) tmax = fmaxf(tmax, fmaxf(s0[j], s1[j]));
            tmax = fmaxf(tmax, __shfl_xor(tmax, 32));
            if (kt == 0 || __any(tmax > 8.0f)) {
                const float dl = (kt == 0) ? tmax : fmaxf(tmax, 0.f);
                const float alpha = (kt == 0) ? 1.0f : __builtin_amdgcn_exp2f(-dl);
                mrun += dl; lrun *= alpha;
#pragma unroll
                for (int j = 0; j < 16; ++j) negm[j] = -mrun;
#pragma unroll
                for (int j = 0; j < 16; ++j) { s0[j] -= dl; s1[j] -= dl; }
#pragma unroll
                for (int i = 0; i < 4; ++i)
#pragma unroll
                    for (int j = 0; j < 16; ++j) o[i][j] *= alpha;
            }
            float ls = 0.f;
#pragma unroll
            for (int j = 0; j < 16; ++j) { s0[j] = __builtin_amdgcn_exp2f(s0[j]); s1[j] = __builtin_amdgcn_exp2f(s1[j]); ls += s0[j] + s1[j]; }
            lrun += ls;
            }
            if (!(PB & 2))
#pragma unroll
            for (int sub = 0; sub < 2; ++sub)
#pragma unroll
                for (int st = 0; st < 2; ++st) {
                    const bf16x8 pf = pack_step(sub ? s1 : s0, st);
                    const ldsp vp = Vb + (32 * sub + 16 * st) * AT_VP;
#pragma unroll
                    for (int blk = 0; blk < 4; ++blk) {
                        const s16x4 lo = vtr(vp + blk * 64), hi = vtr(vp + 8 * AT_VP + blk * 64);
                        const bf16x8 vf = __builtin_shufflevector(lo, hi, 0, 1, 2, 3, 4, 5, 6, 7);
                        o[blk] = MFMA32(vf, pf, o[blk]);
                    }
                }
        }
        if (more && !(PB & 8)) AT_STORE((kt + 1) & 1);
        __syncthreads();
    }
#undef AT_LOAD
#undef AT_STORE
    { const float lt = lrun + __shfl_xor(lrun, 32); const float inv = 1.0f / lt;
#pragma unroll
      for (int i = 0; i < 4; ++i)
#pragma unroll
          for (int j = 0; j < 16; ++j) o[i][j] *= inv; }
    const ldsp ex = lds + AT_EX + wq * 16384 + lane * 4;
    if (map == 1) {
#pragma unroll
        for (int i = 0; i < 4; ++i)
#pragma unroll
            for (int j = 0; j < 16; ++j) *(LAS float*)(ex + (i * 16 + j) * 256) = o[i][j];
    }
    __syncthreads();
    if (map == 0 && !(PB & 1)) {
        float sq = 0.f;
#pragma unroll
        for (int i = 0; i < 4; ++i)
#pragma unroll
            for (int j = 0; j < 16; ++j) { const float d = o[i][j] - lam * *(const LAS float*)(ex + (i * 16 + j) * 256); o[i][j] = d; sq += d * d; }
        sq += __shfl_xor(sq, 32);
        const float rs = rsqrtf(sq * (1.0f / 128.0f) + 1e-6f) * oscale;
        bf16_t* op = MIX + (size_t)(rowbase + qw + r) * DM + h * 128 + 4 * hh;
#pragma unroll
        for (int i = 0; i < 4; ++i)
#pragma unroll
            for (int g4 = 0; g4 < 4; ++g4) {
                const int vd = 32 * i + 8 * g4;
                const f32x4 gn = *(const f32x4*)(gnorm + vd + 4 * hh);
                u32x2 wv; wv.x = cvtpk(o[i][4 * g4] * rs * gn[0], o[i][4 * g4 + 1] * rs * gn[1]); wv.y = cvtpk(o[i][4 * g4 + 2] * rs * gn[2], o[i][4 * g4 + 3] * rs * gn[3]);
                *(u32x2*)(op + vd) = wv;
            }
    }
    __syncthreads();
}

constexpr int HG_P = 272, HG_PT = 144;
constexpr int HG_QH = 0, HG_KH = 64 * HG_P, HG_KHT = 2 * 64 * HG_P, HG_VT = HG_KHT + 128 * HG_PT, HG_SS = HG_VT + 128 * HG_PT, HG_TOT = HG_SS + 128 * HG_P;
constexpr int HG_E2 = HG_TOT + 4096, HG_SSQ = HG_E2 + 512, HG_END = HG_SSQ + 1024;
static_assert(HG_END <= LDS_BYTES - 16, "hgrn LDS map");

template <int MODE>
__device__ __forceinline__ void hgrn_chunk(ldsp lds, int u0, int ustride, const bf16_t* Z, const _Float16* G, bf16_t* TS, float* SC, bf16_t* MIX, const float* gnorm, int lite = 0) {
    int tid = threadIdx.x; asm volatile("" : "+v"(tid));
    const int lane = tid & 63, w = __builtin_amdgcn_readfirstlane(tid >> 6), r = lane & 31, hh = lane >> 5;
    const int kp = (tid & 63) * 2, part = tid >> 6;
    const int vb = w >> 1, tb = w & 1;
    unsigned gr2[8], qr2[8], vr2[8]; u32x4 ssr[4];
#define HG_LOAD(uu) do { const int bh_ = (uu) >> 6, c_ = (uu) & 63, b_ = bh_ >> 2, h_ = bh_ & 3; const size_t r0_ = (size_t)b_ * SEQL + (size_t)c_ * 64 + 8 * part; \
      const unsigned* gp_ = (const unsigned*)(G + r0_ * 512 + h_ * 128 + kp); const unsigned* qp_ = (const unsigned*)(Z + r0_ * ZP + 1536 + h_ * 128 + kp); const unsigned* vp_ = (const unsigned*)(Z + r0_ * ZP + 2048 + h_ * 128 + kp); \
      _Pragma("unroll") for (int i_ = 0; i_ < 8; ++i_) { gr2[i_] = gp_[(size_t)i_ * 256]; vr2[i_] = vp_[(size_t)i_ * (ZP / 2)]; if (MODE == 3) qr2[i_] = qp_[(size_t)i_ * (ZP / 2)]; else qr2[i_] = 0; } \
      if (MODE == 3) { const bf16_t* sl_ = TS + (size_t)(uu) * 16384; _Pragma("unroll") for (int i_ = 0; i_ < 4; ++i_) { const int cid_ = tid + 512 * i_; ssr[i_] = *(const u32x4*)(sl_ + (cid_ >> 4) * 128 + (cid_ & 15) * 8); } } } while (0)
    if (u0 < 2048) HG_LOAD(u0);
#pragma unroll 1
    for (int u = u0; u < 2048; u += ustride) {
    const int bh = u >> 6, c = u & 63, b = bh >> 2, h = bh & 3;
    const size_t row0 = (size_t)b * SEQL + (size_t)c * 64;
    bf16_t* slot = TS + (size_t)u * 16384;
    float g0[8], g1[8], cs0[8], cs1[8];
    { float a0 = 0.f, a1 = 0.f;
#pragma unroll
      for (int i = 0; i < 8; ++i) { g0[i] = (float)__builtin_bit_cast(_Float16, (unsigned short)(gr2[i] & 0xffffu)); g1[i] = (float)__builtin_bit_cast(_Float16, (unsigned short)(gr2[i] >> 16));
          a0 += g0[i]; a1 += g1[i]; cs0[i] = a0; cs1[i] = a1; } }
    *(LAS f32x2_t*)(lds + HG_TOT + (part * 128 + kp) * 4) = (f32x2_t){cs0[7], cs1[7]};
    __syncthreads();
    { float off0 = 0.f, off1 = 0.f, rho0 = 0.f, rho1 = 0.f, bl0 = 0.f, bl1 = 0.f;
#pragma unroll
      for (int p = 0; p < 8; ++p) { const f32x2_t tt = *(const LAS f32x2_t*)(lds + HG_TOT + (p * 128 + kp) * 4);
          if (p < part) { off0 += tt.x; off1 += tt.y; }
          if (p < 4) { rho0 += tt.x; rho1 += tt.y; }
          bl0 += tt.x; bl1 += tt.y; }
      unsigned kA[4], kB[4], vA[4], vB[4];
#pragma unroll
      for (int i = 0; i < 8; i += 2) {
          const int t = 8 * part + i;
          const float b00 = off0 + cs0[i], b01 = off1 + cs1[i], b10 = off0 + cs0[i + 1], b11 = off1 + cs1[i + 1];
          const float k00 = (1.0f - __expf(g0[i])) * __expf(rho0 - b00), k01 = (1.0f - __expf(g1[i])) * __expf(rho1 - b01);
          const float k10 = (1.0f - __expf(g0[i + 1])) * __expf(rho0 - b10), k11 = (1.0f - __expf(g1[i + 1])) * __expf(rho1 - b11);
          if (MODE == 3) {
              const float q00 = __uint_as_float(qr2[i] << 16) * __expf(b00 - rho0), q01 = __uint_as_float(qr2[i] & 0xffff0000u) * __expf(b01 - rho1);
              const float q10 = __uint_as_float(qr2[i + 1] << 16) * __expf(b10 - rho0), q11 = __uint_as_float(qr2[i + 1] & 0xffff0000u) * __expf(b11 - rho1);
              *(LAS unsigned*)(lds + HG_QH + t * HG_P + kp * 2) = cvtpk(q00, q01);
              *(LAS unsigned*)(lds + HG_QH + (t + 1) * HG_P + kp * 2) = cvtpk(q10, q11);
              *(LAS unsigned*)(lds + HG_KH + t * HG_P + kp * 2) = cvtpk(k00, k01);
              *(LAS unsigned*)(lds + HG_KH + (t + 1) * HG_P + kp * 2) = cvtpk(k10, k11);
          }
          kA[i >> 1] = cvtpk(k00, k10); kB[i >> 1] = cvtpk(k01, k11);
          vA[i >> 1] = (vr2[i] & 0xffffu) | (vr2[i + 1] << 16); vB[i >> 1] = (vr2[i] >> 16) | (vr2[i + 1] & 0xffff0000u);
      }
      if (MODE == 1) {
          *(LAS u32x4*)(lds + HG_KHT + kp * HG_PT + part * 16) = (u32x4){kA[0], kA[1], kA[2], kA[3]};
          *(LAS u32x4*)(lds + HG_KHT + (kp + 1) * HG_PT + part * 16) = (u32x4){kB[0], kB[1], kB[2], kB[3]};
      }
      *(LAS u32x4*)(lds + HG_VT + kp * HG_PT + part * 16) = (u32x4){vA[0], vA[1], vA[2], vA[3]};
      *(LAS u32x4*)(lds + HG_VT + (kp + 1) * HG_PT + part * 16) = (u32x4){vB[0], vB[1], vB[2], vB[3]};
      if (MODE == 1 && part == 0) {
          *(LAS f32x2_t*)(lds + HG_E2 + kp * 4) = (f32x2_t){__expf(bl0 - rho0), __expf(bl1 - rho1)};
          *(f32x2_t*)(SC + (size_t)u * 256 + kp) = (f32x2_t){__expf(bl0), __expf(bl1)};
          *(f32x2_t*)(SC + (size_t)u * 256 + 128 + kp) = (f32x2_t){__expf(rho0), __expf(rho1)};
      }
      if (MODE == 3) {
#pragma unroll
          for (int i = 0; i < 4; ++i) { const int cid = tid + 512 * i; *(LAS u32x4*)(lds + HG_SS + (cid >> 4) * HG_P + (cid & 15) * 16) = ssr[i]; }
      }
    }
    __syncthreads();
    if (u + ustride < 2048) HG_LOAD(u + ustride);
    u32x2 gtr[4];
    if (MODE == 3) {
        const size_t grow = row0 + 32 * tb + r;
#pragma unroll
        for (int g4 = 0; g4 < 4; ++g4) gtr[g4] = *(const u32x2*)(Z + grow * ZP + 2560 + h * 128 + 32 * vb + 8 * g4 + 4 * hh);
    }
    if (lite) {
    } else if (MODE == 1) {
#pragma unroll
        for (int i = 0; i < 2; ++i) {
            const int kb = 2 * tb + i;
            f32x16 T;
#pragma unroll
            for (int j = 0; j < 16; ++j) T[j] = 0.f;
#pragma unroll
            for (int s = 0; s < 4; ++s) {
                const bf16x8 af = *(const LAS bf16x8*)(lds + HG_VT + (32 * vb + r) * HG_PT + (16 * s + 8 * hh) * 2);
                const bf16x8 bfr = *(const LAS bf16x8*)(lds + HG_KHT + (32 * kb + r) * HG_PT + (16 * s + 8 * hh) * 2);
                T = MFMA32(af, bfr, T);
            }
            const float e2 = *(const LAS float*)(lds + HG_E2 + (32 * kb + r) * 4);
#pragma unroll
            for (int j = 0; j < 16; ++j) {
                const unsigned pk = cvtpk(T[j] * e2, 0.f);
                slot[(32 * vb + crow(j, hh)) * 128 + 32 * kb + r] = (unsigned short)(pk & 0xffffu);
            }
        }
    } else {
        bf16x8 qf[8];
#pragma unroll
        for (int s = 0; s < 8; ++s) qf[s] = *(const LAS bf16x8*)(lds + HG_QH + (32 * tb + r) * HG_P + (16 * s + 8 * hh) * 2);
        f32x16 at0, at1, out;
#pragma unroll
        for (int j = 0; j < 16; ++j) { at0[j] = 0.f; at1[j] = 0.f; out[j] = 0.f; }
#pragma unroll
        for (int s = 0; s < 8; ++s) { const bf16x8 kf = *(const LAS bf16x8*)(lds + HG_KH + r * HG_P + (16 * s + 8 * hh) * 2); at0 = MFMA32(kf, qf[s], at0); }
        if (tb == 1) {
#pragma unroll
            for (int s = 0; s < 8; ++s) { const bf16x8 kf = *(const LAS bf16x8*)(lds + HG_KH + (32 + r) * HG_P + (16 * s + 8 * hh) * 2); at1 = MFMA32(kf, qf[s], at1); }
#pragma unroll
            for (int j = 0; j < 16; ++j) if (crow(j, hh) > r) at1[j] = 0.f;
        } else {
#pragma unroll
            for (int j = 0; j < 16; ++j) if (crow(j, hh) > r) at0[j] = 0.f;
        }
        { const ldsp vtp = lds + HG_VT + (32 * vb + r) * HG_PT + 8 * hh;
#pragma unroll
          for (int s2 = 0; s2 < 2; ++s2) {
              const bf16x8 pf = pack_step(at0, s2);
              const s16x4 lo = *(const LAS s16x4*)(vtp + 32 * s2), hi = *(const LAS s16x4*)(vtp + 32 * s2 + 16);
              out = MFMA32(__builtin_shufflevector(lo, hi, 0, 1, 2, 3, 4, 5, 6, 7), pf, out);
          }
          if (tb == 1) {
#pragma unroll
              for (int s2 = 0; s2 < 2; ++s2) {
                  const bf16x8 pf = pack_step(at1, s2);
                  const s16x4 lo = *(const LAS s16x4*)(vtp + 64 + 32 * s2), hi = *(const LAS s16x4*)(vtp + 64 + 32 * s2 + 16);
                  out = MFMA32(__builtin_shufflevector(lo, hi, 0, 1, 2, 3, 4, 5, 6, 7), pf, out);
              }
          } }
#pragma unroll
        for (int s = 0; s < 8; ++s) { const bf16x8 sf = *(const LAS bf16x8*)(lds + HG_SS + (32 * vb + r) * HG_P + (16 * s + 8 * hh) * 2); out = MFMA32(sf, qf[s], out); }
        { float sq = 0.f;
#pragma unroll
          for (int j = 0; j < 16; ++j) sq += out[j] * out[j];
          sq += __shfl_xor(sq, 32);
          if (hh == 0) *(LAS float*)(lds + HG_SSQ + (vb * 64 + 32 * tb + r) * 4) = sq; }
        __syncthreads();
        { const int tl = 32 * tb + r;
          const float tot = (*(const LAS float*)(lds + HG_SSQ + tl * 4) + *(const LAS float*)(lds + HG_SSQ + (64 + tl) * 4)) + (*(const LAS float*)(lds + HG_SSQ + (128 + tl) * 4) + *(const LAS float*)(lds + HG_SSQ + (192 + tl) * 4));
          const float rs = rsqrtf(tot * (1.0f / 128.0f) + 1e-6f);
          const size_t row = row0 + tl;
#pragma unroll
          for (int g4 = 0; g4 < 4; ++g4) {
              const int v0 = 32 * vb + 8 * g4 + 4 * hh;
              const u32x2 gt = gtr[g4];
              const f32x4 gn = *(const f32x4*)(gnorm + v0);
              const float a0 = out[4 * g4] * rs * gn[0] * __uint_as_float(gt.x << 16), a1 = out[4 * g4 + 1] * rs * gn[1] * __uint_as_float(gt.x & 0xffff0000u);
              const float a2 = out[4 * g4 + 2] * rs * gn[2] * __uint_as_float(gt.y << 16), a3 = out[4 * g4 + 3] * rs * gn[3] * __uint_as_float(gt.y & 0xffff0000u);
              u32x2 wv; wv.x = cvtpk(a0, a1); wv.y = cvtpk(a2, a3);
              *(u32x2*)(MIX + row * DM + 512 + h * 128 + v0) = wv;
          } }
    }
    __syncthreads();
    }
#undef HG_LOAD
}

__device__ __forceinline__ void hgrn_scan(int bh, bf16_t* TS, const float* SC) {
    int tid = threadIdx.x; asm volatile("" : "+v"(tid));
    const int k8 = (tid & 15) * 8, v0 = tid >> 4;
    float S[4][8];
#pragma unroll
    for (int i = 0; i < 4; ++i)
#pragma unroll
        for (int j = 0; j < 8; ++j) S[i][j] = 0.f;
    bf16_t* base = TS + (size_t)bh * 64 * 16384 + (size_t)v0 * 128 + k8;
    const float* scb = SC + (size_t)bh * 64 * 256 + k8;
    u32x4 Tr[4][4]; f32x4 dlr[4][2], err[4][2];
#define HS_LOAD(d, c) do { _Pragma("unroll") for (int i_ = 0; i_ < 4; ++i_) Tr[d][i_] = *(const u32x4*)(base + (size_t)(c) * 16384 + i_ * 32 * 128); \
        dlr[d][0] = *(const f32x4*)(scb + (size_t)(c) * 256); dlr[d][1] = *(const f32x4*)(scb + (size_t)(c) * 256 + 4); \
        err[d][0] = *(const f32x4*)(scb + (size_t)(c) * 256 + 128); err[d][1] = *(const f32x4*)(scb + (size_t)(c) * 256 + 132); } while (0)
#pragma unroll
    for (int d = 0; d < 4; ++d) HS_LOAD(d, d);
#pragma unroll 1
    for (int c0 = 0; c0 < 64; c0 += 4) {
#pragma unroll
        for (int d = 0; d < 4; ++d) {
            const int c = c0 + d;
            float dl[8], er[8];
#pragma unroll
            for (int j = 0; j < 4; ++j) { dl[j] = dlr[d][0][j]; dl[4 + j] = dlr[d][1][j]; er[j] = err[d][0][j]; er[4 + j] = err[d][1][j]; }
#pragma unroll
            for (int i = 0; i < 4; ++i) {
                const u32x4 t = Tr[d][i];
                u32x4 o; o.x = cvtpk(S[i][0] * er[0], S[i][1] * er[1]); o.y = cvtpk(S[i][2] * er[2], S[i][3] * er[3]); o.z = cvtpk(S[i][4] * er[4], S[i][5] * er[5]); o.w = cvtpk(S[i][6] * er[6], S[i][7] * er[7]);
                S[i][0] = S[i][0] * dl[0] + __uint_as_float(t.x << 16); S[i][1] = S[i][1] * dl[1] + __uint_as_float(t.x & 0xffff0000u);
                S[i][2] = S[i][2] * dl[2] + __uint_as_float(t.y << 16); S[i][3] = S[i][3] * dl[3] + __uint_as_float(t.y & 0xffff0000u);
                S[i][4] = S[i][4] * dl[4] + __uint_as_float(t.z << 16); S[i][5] = S[i][5] * dl[5] + __uint_as_float(t.z & 0xffff0000u);
                S[i][6] = S[i][6] * dl[6] + __uint_as_float(t.w << 16); S[i][7] = S[i][7] * dl[7] + __uint_as_float(t.w & 0xffff0000u);
                *(u32x4*)(base + (size_t)c * 16384 + i * 32 * 128) = o;
            }
            if (c + 4 < 64) HS_LOAD(d, c + 4);
        }
    }
#undef HS_LOAD
}


#define XB_TMO      128
#define XB_XCNT(j)  (256  + 64 * (j))
#define XB_XSUB(j)  (1280 + 64 * (j))
#define XB_XGEN(j)  (2304 + 64 * (j))
#define XB_TOP      3328
#define XB_TOPGEN   3392
#define XCD_BAR_WORDS 3456
#define XB_SPIN_CAP (1u << 18)

__device__ __forceinline__ unsigned xb_ld(unsigned* p)              { return __hip_atomic_load(p, __ATOMIC_RELAXED, __HIP_MEMORY_SCOPE_AGENT); }
__device__ __forceinline__ unsigned xb_add(unsigned* p, unsigned v) { return __hip_atomic_fetch_add(p, v, __ATOMIC_RELAXED, __HIP_MEMORY_SCOPE_AGENT); }
__device__ __forceinline__ unsigned xb_xcc_id() { return (unsigned)__builtin_amdgcn_s_getreg((3 << 11) | 20) & 0xFu; }
#define XB_SPIN(cond, bar) do { unsigned _sp = 0; while (cond) { __builtin_amdgcn_s_sleep(1); \
    if ((++_sp & 255u) == 0u) { if (xb_ld(&(bar)[XB_TMO])) break; if (_sp > XB_SPIN_CAP) { atomicAdd(&(bar)[XB_TMO], 1u); break; } } } } while (0)

struct XcdBarrier {
    unsigned* bar; unsigned x;
    volatile LAS unsigned* st;
};

__device__ __forceinline__ XcdBarrier xcd_barrier_post(unsigned* bar, volatile LAS unsigned* st) {
    XcdBarrier b; b.bar = bar; b.x = xb_xcc_id(); b.st = st;
    if (threadIdx.x == 0) (void)xb_add(&bar[XB_XCNT(b.x)], 1u);
    return b;
}
__device__ __forceinline__ void xcd_barrier_complete(unsigned* bar, unsigned x, unsigned& nloc, unsigned& nx) {
    const unsigned G = gridDim.x * gridDim.y * gridDim.z;
    unsigned sum, cnt, mine, sp = 0u;
    for (;;) {
        sum = 0u; cnt = 0u; mine = 0u;
#pragma unroll
        for (unsigned j = 0; j < 16; ++j) { const unsigned c = xb_ld(&bar[XB_XCNT(j)]); sum += c; cnt += (c > 0u) ? 1u : 0u; mine = (j == x) ? c : mine; }
        if (sum == G) break;
        __builtin_amdgcn_s_sleep(1);
        if ((++sp & 255u) == 0u) { if (xb_ld(&bar[XB_TMO])) break; if (sp > XB_SPIN_CAP) { atomicAdd(&bar[XB_TMO], 1u); break; } }
    }
    nloc = mine > 0u ? mine : 1u; nx = cnt > 0u ? cnt : 1u;
}

__device__ __forceinline__ void xcd_barrier(const XcdBarrier& b) {
    asm volatile("s_waitcnt vmcnt(0)" ::: "memory");
    __syncthreads();
    if (threadIdx.x == 0) {
        unsigned* bar = b.bar;
        __builtin_amdgcn_s_waitcnt(0);
        unsigned nloc = b.st[0], nx = b.st[1];
        if (nloc == 0u) { xcd_barrier_complete(bar, b.x, nloc, nx); b.st[0] = nloc; b.st[1] = nx; }
        const unsigned old = xb_add(&bar[XB_XSUB(b.x)], 1u);
        const unsigned gen = old / nloc;
        if (old + 1u == (gen + 1u) * nloc) {
            __builtin_amdgcn_fence(__ATOMIC_RELEASE, "agent");
            asm volatile("s_waitcnt vmcnt(0)" ::: "memory");
            const unsigned og = xb_add(&bar[XB_TOP], 1u);
            const unsigned tg = og / nx;
            if (og + 1u == (tg + 1u) * nx) xb_add(&bar[XB_TOPGEN], 1u);
            else XB_SPIN(xb_ld(&bar[XB_TOPGEN]) == tg, bar);
            __builtin_amdgcn_fence(__ATOMIC_ACQUIRE, "agent");
            xb_add(&bar[XB_XGEN(b.x)], 1u);
            asm volatile("s_waitcnt vmcnt(0)" ::: "memory");
        } else {
            XB_SPIN(xb_ld(&bar[XB_XGEN(b.x)]) == gen, bar);
            __builtin_amdgcn_fence(__ATOMIC_ACQUIRE, "agent");
            asm volatile("s_waitcnt vmcnt(0)" ::: "memory");
        }
    }
    __syncthreads();
}

__device__ __forceinline__ void grid_seam_cg(cg::grid_group& grid) {
    asm volatile("s_waitcnt vmcnt(0) lgkmcnt(0)" ::: "memory");
    __syncthreads();
    if (threadIdx.x == 0) asm volatile("buffer_wbl2 sc1\n\ts_waitcnt vmcnt(0)" ::: "memory");
    grid.sync();
    asm volatile("buffer_inv sc1\n\ts_waitcnt vmcnt(0)" ::: "memory");
}
__global__ void __launch_bounds__(NTHR, 2) mega_fwd(Args args) {
    extern __shared__ __attribute__((aligned(16))) unsigned char lds_raw[];
    cg::grid_group grid = cg::this_grid();
    const ldsp lds = (ldsp)lds_raw;
    const int tid = threadIdx.x, lane = tid & 63, wave = __builtin_amdgcn_readfirstlane(tid >> 6);
    const int G = gridDim.x, bx = blockIdx.x;
    unsigned char* ws = args.ws;
    unsigned* ctl = (unsigned*)(ws + WS_CTL);
    float* ctlf = (float*)(ws + WS_CTL);
    unsigned long long* SS = (unsigned long long*)(ws + WS_SS);
    bf16_t* XB = (bf16_t*)(ws + WS_XB);
    bf16_t* Zb = (bf16_t*)(ws + WS_Z);
    _Float16* Gb = (_Float16*)(ws + WS_G);
    bf16_t* Ub = (bf16_t*)(ws + WS_U);
    bf16_t* MIXb = (bf16_t*)(ws + WS_MIX);
    const float* x_in = args.in[0];
    float* X = args.out;
    LAS int* const sh_idx = (LAS int*)(lds + LDS_BYTES - 16);
    if (tid < 8) *(LAS unsigned*)(lds + LDS_BYTES - 32 + 4 * tid) = 0u;
    __syncthreads();
    const XcdBarrier xbar = xcd_barrier_post(ctl + CW_BAR, (volatile LAS unsigned*)(lds + LDS_BYTES - 32));

    {
        const int gw = bx * NWAVES + wave, NGW = G * NWAVES;
        LAS float* scr = (LAS float*)(lds + wave * 16384);
        constexpr int I_TOT = DEPTH * ((DM / 64) * (INC / 32) + (DM / 64) * (DM / 32) + (DM / 64) * (FF / 32) + (FF / 64) * (DM / 32));
        { f32x4 wv[8], wn[8]; float gg[8], gn[8];
          P0Item cur = p0_decode(args, ws, gw < I_TOT ? gw : 0), nxt = cur;
          if (gw < I_TOT) p0_load(cur, lane, wv, gg);
#pragma unroll 1
          for (int it = gw; it < I_TOT; it += NGW) {
              const bool has = (it + NGW < I_TOT);
              if (has) { nxt = p0_decode(args, ws, it + NGW); p0_load(nxt, lane, wn, gn); }
              p0_store(cur, lane, scr, wv, gg);
              if (has) { cur = nxt;
#pragma unroll
                  for (int i = 0; i < 8; ++i) { wv[i] = wn[i]; gg[i] = gn[i]; } }
          } }
        { f32x4 v[4], vn[4];
          if (gw < M_TOK) { const f32x4* xr = (const f32x4*)(x_in + (size_t)gw * DM) + lane;
#pragma unroll
              for (int j = 0; j < 4; ++j) v[j] = __builtin_nontemporal_load(xr + 64 * j); }
#pragma unroll 1
          for (int m = gw; m < M_TOK; m += NGW) {
              const bool has = (m + NGW < M_TOK);
              if (has) { const f32x4* xr = (const f32x4*)(x_in + (size_t)(m + NGW) * DM) + lane;
#pragma unroll
                  for (int j = 0; j < 4; ++j) vn[j] = __builtin_nontemporal_load(xr + 64 * j); }
              float s2 = 0.f;
#pragma unroll
              for (int j = 0; j < 4; ++j) s2 += (v[j].x * v[j].x + v[j].y * v[j].y) + (v[j].z * v[j].z + v[j].w * v[j].w);
              s2 = wave_sum(s2);
              u32x2* o8 = (u32x2*)(XB + (size_t)m * DM) + lane;
#pragma unroll
              for (int j = 0; j < 4; ++j) { u32x2 wv2; wv2.x = cvtpk(v[j].x, v[j].y); wv2.y = cvtpk(v[j].z, v[j].w); o8[64 * j] = wv2; }
              if (lane == 0) SS[m] = (unsigned long long)(s2 * pg8::SS_FIX);
              if (has) {
#pragma unroll
                  for (int j = 0; j < 4; ++j) v[j] = vn[j]; }
          } }
        for (int i = bx * NTHR + tid; i < 8 * M_TOK; i += G * NTHR) SS[M_TOK + i] = 0ull;
        if (bx == 0) {
            { const float* lg = args.in[5]; const int c = tid;
              const float a0 = lg[c], a1 = lg[512 + c], a2 = lg[1024 + c], a3 = lg[1536 + c];
              const float mx = fmaxf(fmaxf(a0, a1), fmaxf(a2, a3));
              const float e0 = expf(a0 - mx), e1 = expf(a1 - mx), e2 = expf(a2 - mx), e3 = expf(a3 - mx);
              const float inv = 1.0f / ((e0 + e1) + (e2 + e3));
              ctlf[CW_LB + c] = 0.f; ctlf[CW_LB + 512 + c] = e1 * inv; ctlf[CW_LB + 1024 + c] = (e1 + e2) * inv; ctlf[CW_LB + 1536 + c] = (e1 + e2 + e3) * inv; }
            if (wave < DEPTH) {
                const float* lq = args.in[3] + wave * 256;
                const float p1 = wave_sum(lq[lane] * lq[64 + lane]), p2 = wave_sum(lq[128 + lane] * lq[192 + lane]);
                if (lane == 0) ctlf[CW_LAM + wave] = expf(p1) - expf(p2) + (0.8f - 0.6f * expf(-0.3f * (float)wave));
            }
        }
    }
    if (args.ws == nullptr) grid_seam_cg(grid);
    xcd_barrier(xbar);

#pragma unroll 1
    for (int step = 0; step < 7 * DEPTH; ++step) {
        const int l = step / 7, ph = step - 7 * l;
        unsigned char* wl = ws + WS_W + (size_t)l * W_LAYER;
        unsigned long long* ss1 = SS + (size_t)(2 * l) * M_TOK;
        unsigned long long* ss2 = SS + (size_t)(2 * l + 1) * M_TOK;
        unsigned long long* ss3 = SS + (size_t)(2 * l + 2) * M_TOK;
        bf16_t* TSb = (bf16_t*)args.out; float* SCb = (float*)(ws + WS_SC);
        const float* gnh = args.in[6] + l * 128;
#ifndef PROBE_REPEAT_PH
#define PROBE_REPEAT_PH -1
#endif
#ifndef PROBE_LITE
#define PROBE_LITE 0
#endif
#pragma unroll 1
        for (int rep = 0; rep < (ph == PROBE_REPEAT_PH ? 2 : 1); ++rep) {
        if (ph == 1) {
            hgrn_chunk<1>(lds, bx, G, Zb, Gb, TSb, SCb, MIXb, gnh);
        } else if (ph == 3) {
            hgrn_chunk<3>(lds, bx, G, Zb, Gb, TSb, SCb, MIXb, gnh, PROBE_LITE * rep);
        } else if (ph == 2) {
            const float lam = ctlf[CW_LAM + l];
            const float oscale = 1.0f - (0.8f - 0.6f * expf(-0.3f * (float)l));
            const float* relb = args.in[11];
            const float* gna = args.in[4] + l * 128;
            const int xcc = (int)(xb_xcc_id() & 7u);
            attn_bias_tables(lds, relb);
#pragma unroll 1
            for (int qi = 0; qi < 8; ++qi) {
                const int xq = (xcc + qi) & 7;
                unsigned* qctr = ctl + CW_QCTR + 64 * ((l + DEPTH * rep) * 8 + xq);
                for (;;) {
                    if (tid == 0) *sh_idx = (rep ? 4 : 0) + (int)__hip_atomic_fetch_add(qctr, 1u, __ATOMIC_RELAXED, __HIP_MEMORY_SCOPE_AGENT);
                    __syncthreads();
                    const int idx = *sh_idx;
                    __syncthreads();
                    if (idx >= 4 + 128) break;
#ifdef PROBE_SCAN_LAST
                    if (idx >= 128) hgrn_scan(4 * xq + idx - 128, TSb, SCb);
                    else { const int a = idx, pr = a >> 6,
#else
                    if (idx < 4) hgrn_scan(4 * xq + idx, TSb, SCb);
                    else { const int a = idx - 4, pr = a >> 6,
#endif
                           qb = 31 - ((a & 63) >> 1), bh = 4 * xq + 2 * pr + (a & 1);
#ifdef PROBE_ATT
                           if (rep) attn_unit<PROBE_ATT>(lds, bh >> 2, bh & 3, qb, Zb, MIXb, relb, gna, lam, oscale); else
#endif
                           attn_unit<0>(lds, bh >> 2, bh & 3, qb, Zb, MIXb, relb, gna, lam, oscale); }
                }
            }
        } else {
            pg8::Gemm g; pg8::EpiAny E{};
            if (ph == 0)      { g = pg8::Gemm{XB, (const bf16_t*)(wl + W_IN), M_TOK, INC, DM}; E.mode = 0; E.Z = Zb; E.G = Gb; E.ss = ss1; E.lb = ctlf + CW_LB + 512 * l; }
            else if (ph == 4) { g = pg8::Gemm{MIXb, (const bf16_t*)(wl + W_OUT), M_TOK, DM, DM}; E.mode = 1; E.ascale = 1.0f; E.xb = XB; E.ssn = ss2; }
            else if (ph == 5) { g = pg8::Gemm{XB, (const bf16_t*)(wl + W_UP), M_TOK, FF, DM}; E.mode = 2; E.Z = Ub; E.ss = ss2; }
            else              { g = pg8::Gemm{Ub, (const bf16_t*)(wl + W_DOWN), M_TOK, DM, FF, 1}; E.mode = 1; E.ascale = 1.0f; E.xb = XB; E.ssn = ss3; }
            pg8::StaticOrder S; S.init(M_TOK, g.N, G, bx, ph == 6);
            pg8::gemm_phase<pg8::EpiAny, pg8::StaticOrder, true, true>(lds, g, S, E);
        }
        xcd_barrier(xbar);
#ifdef PROBE_SEAM2
        xcd_barrier(xbar);
#endif
        }
    }
    {
        const int gw = bx * NWAVES + wave, NGW = G * NWAVES;
        const float* fg = args.in[12];
        const unsigned long long* ssf = SS + (size_t)8 * M_TOK;
        f32x4 gv[4];
#pragma unroll
        for (int j = 0; j < 4; ++j) gv[j] = ((const f32x4*)fg)[lane + 64 * j];
        for (int m = gw; m < M_TOK; m += NGW) {
            const u32x2* xr = (const u32x2*)(XB + (size_t)m * DM) + lane;
            f32x4* orow = (f32x4*)(X + (size_t)m * DM) + lane;
            const float rs = rsqrtf((float)ssf[m] * pg8::SS_INV + 1e-6f);
#pragma unroll
            for (int j = 0; j < 4; ++j) { const u32x2 xw = xr[64 * j];
                const f32x4 v = {__uint_as_float(xw.x << 16), __uint_as_float(xw.x & 0xffff0000u), __uint_as_float(xw.y << 16), __uint_as_float(xw.y & 0xffff0000u)};
                __builtin_nontemporal_store(v * rs * gv[j], orow + 64 * j); }
        }
    }
}

extern "C" void kernel_launch(void* const* d_in, const int* in_sizes, int n_in, void* d_out, int out_size, void* d_ws, size_t ws_size, hipStream_t stream) {
    static int grid = 0;
    if (grid == 0) {
        if (n_in != 13 || ws_size < WS_END) { fprintf(stderr, "kernel_launch: unexpected n_in %d / ws_size %zu (need %zu)\n", n_in, ws_size, (size_t)WS_END); grid = -1; return; }
        int dev = 0, cus = 0, per_cu = 0;
        hipGetDevice(&dev);
        hipDeviceGetAttribute(&cus, hipDeviceAttributeMultiprocessorCount, dev);
        if (hipFuncSetAttribute((const void*)mega_fwd, hipFuncAttributeMaxDynamicSharedMemorySize, LDS_BYTES) != hipSuccess) { fprintf(stderr, "kernel_launch: hipFuncSetAttribute failed\n"); grid = -1; return; }
        if (hipOccupancyMaxActiveBlocksPerMultiprocessor(&per_cu, (const void*)mega_fwd, NTHR, LDS_BYTES) != hipSuccess || per_cu < 1) { fprintf(stderr, "kernel_launch: occupancy query says %d\n", per_cu); per_cu = 1; }
        (void)hipGetLastError();
        grid = cus * 1;
    }
    if (grid < 0) return;
    if (hipMemsetAsync((char*)d_ws + WS_CTL, 0, CTL_ZERO_BYTES, stream) != hipSuccess) { fprintf(stderr, "kernel_launch: hipMemsetAsync failed\n"); return; }
    Args a{};
    for (int i = 0; i < 13; ++i) a.in[i] = (const float*)d_in[i];
    a.out = (float*)d_out; a.ws = (unsigned char*)d_ws;
    void* kargs[] = {&a};
    hipError_t e = hipLaunchCooperativeKernel((const void*)mega_fwd, dim3(grid), dim3(NTHR), kargs, LDS_BYTES, stream);
    if (e != hipSuccess) fprintf(stderr, "kernel_launch: cooperative launch failed: %s (grid %d)\n", hipGetErrorString(e), grid);
}
```

```cpp
#include <hip/hip_runtime.h>
#include <hip/hip_cooperative_groups.h>
#include <cstdio>
#include <cstdint>
namespace cg = cooperative_groups;
namespace pg8 {
#define PG8_LAS __attribute__((address_space(3)))
typedef unsigned short bf16_t;
typedef short bf16x8 __attribute__((ext_vector_type(8)));
typedef float f32x4 __attribute__((ext_vector_type(4)));
typedef unsigned u32x4 __attribute__((ext_vector_type(4)));
constexpr int BM = 256, BK = 64, HALF = 128, HTB = HALF * BK * 2  , STAGE_BYTES = 8 * HTB, NXCD = 8, WGM = 8;

__host__ __device__ __forceinline__ int lds_byte(int r, int c) { const int st = (r >> 4) * 2 + (c >> 5), rr = r & 15, cc = c & 31, ob = rr * 64 + cc * 2; return st * 1024 + (ob ^ (((ob >> 9) & 1) << 5)); }
__host__ __device__ __forceinline__ void stage_rc(int b, int& R, int& C) { const int st = b / 1024, sb = b % 1024, swz = sb ^ (((sb >> 9) & 1) << 5); R = (st >> 1) * 16 + swz / 64; C = (st & 1) * 32 + (swz % 64) / 2; }
__host__ __device__ __forceinline__ int perm32(int rho) { const int n = rho >> 4, i = rho & 15; return 8 * (i >> 2) + 4 * n + (i & 3); }

struct Unit { int pm, pn; };
struct Gemm { const bf16_t* A; const bf16_t* Bt; int M, N, K; int ablk; };

struct StaticOrder {
    int nM, nN, nwg, G, c, rev, pm0;
    __host__ __device__ void init(int M, int N, int G_, int c_, int rev_ = 0, int pm0_ = 0) { nM = M / BM; nN = N / BM; nwg = nM * nN; G = G_; c = c_; rev = (rev_ && nwg % G_ == 0) ? 1 : 0; pm0 = pm0_; }
    __host__ __device__ bool next(int i, Unit& u) const {
        if (rev && i >= nwg / G) return false;
        const long L = (long)(rev ? nwg / G - 1 - i : i) * G + c; if (L >= nwg) return false;
        int wgid = (int)L; { const int q = nwg / NXCD, r = nwg % NXCD, xcd = wgid % NXCD, off = wgid / NXCD; wgid = (xcd < r ? xcd * (q + 1) : r * (q + 1) + (xcd - r) * q) + off; }
        const int nig = WGM * nN, gid = wgid / nig, fm = gid * WGM, gsz = (nM - fm) < WGM ? (nM - fm) : WGM;
        u.pm = pm0 + fm + ((wgid % nig) % gsz); u.pn = (wgid % nig) / gsz; return true;
    }
    __device__ __forceinline__ void a_ready(const Unit&) const {}
    __device__ __forceinline__ void done(const Unit&) const {}
};

__device__ __forceinline__ unsigned cvt_pk_bf16(float lo, float hi) { unsigned r; asm volatile("v_cvt_pk_bf16_f32 %0, %1, %2" : "=v"(r) : "v"(lo), "v"(hi)); return r; }
typedef float f32x2 __attribute__((ext_vector_type(2)));
typedef unsigned u32x2 __attribute__((ext_vector_type(2)));
typedef _Float16 h16x8 __attribute__((ext_vector_type(8)));
__device__ __forceinline__ float silu_f(float x) { return x * __builtin_amdgcn_rcpf(1.0f + __expf(-x)); }
constexpr float SS_FIX = 1048576.0f, SS_INV = 1.0f / (1024.0f * 1048576.0f);
constexpr float QSCALE = 0.125f * 1.4426950408889634f;

struct EpiAny {
    static constexpr bool PERM = true, AFTER_DRAIN = false;
    int mode;
    bf16_t* Z; _Float16* G; const unsigned long long* ss; const float* lb;
    bf16_t* xb; unsigned long long* ssn; float ascale;
    __device__ __forceinline__ void operator()(const f32x4 (&acc)[2][2][4][2], const Unit& u, int wr, int wc, int fr, int fq) const {
        if (mode == 0) epi_in(acc, u, wr, wc, fr, fq); else if (mode == 1) epi_res(acc, u, wr, wc, fr, fq); else epi_up(acc, u, wr, wc, fr, fq);
    }
    __device__ __forceinline__ void epi_in(const f32x4 (&acc)[2][2][4][2], const Unit& u, int wr, int wc, int fr, int fq) const {
        const int row0 = u.pm * BM + wr * 64 + fr;
        const int grp = u.pn >> 1;
        const int cin = wc * 32 + 8 * fq;
        const int zc0 = (grp < 4 ? u.pn : u.pn - 2) * BM + cin;
        const int gc0 = (u.pn - 8) * BM + cin;
#pragma unroll
        for (int ai = 0; ai < 2; ++ai)
#pragma unroll
            for (int m = 0; m < 4; ++m) {
                const int row = row0 + ai * HALF + m * 16;
                const float rs = rsqrtf((float)ss[row] * SS_INV + 1e-6f);
#pragma unroll
                for (int bj = 0; bj < 2; ++bj) {
                    f32x4 v0 = acc[ai][bj][m][0] * rs, v1 = acc[ai][bj][m][1] * rs;
                    if (grp == 4) {
                        const int gc = gc0 + bj * HALF;
                        const f32x4 l0 = *(const f32x4*)(lb + gc), l1 = *(const f32x4*)(lb + gc + 4);
                        f32x4 o0, o1;
#pragma unroll
                        for (int j = 0; j < 4; ++j) {
                            o0[j] = __logf(l0[j] + (1.0f - l0[j]) * __builtin_amdgcn_rcpf(1.0f + __expf(-v0[j])));
                            o1[j] = __logf(l1[j] + (1.0f - l1[j]) * __builtin_amdgcn_rcpf(1.0f + __expf(-v1[j])));
                        }
                        h16x8 hv;
#pragma unroll
                        for (int j = 0; j < 4; ++j) { hv[j] = (_Float16)o0[j]; hv[4 + j] = (_Float16)o1[j]; }
                        *(h16x8*)(G + (size_t)row * 512 + gc) = hv;
                    } else {
                        if (grp == 0) { v0 = v0 * QSCALE; v1 = v1 * QSCALE; }
                        else if (grp == 3 || grp == 6) {
#pragma unroll
                            for (int j = 0; j < 4; ++j) { v0[j] = silu_f(v0[j]); v1[j] = silu_f(v1[j]); }
                        }
                        u32x4 w; w.x = cvt_pk_bf16(v0[0], v0[1]); w.y = cvt_pk_bf16(v0[2], v0[3]); w.z = cvt_pk_bf16(v1[0], v1[1]); w.w = cvt_pk_bf16(v1[2], v1[3]);
                        *(u32x4*)(Z + (size_t)row * 3072 + zc0 + bj * HALF) = w;
                    }
                }
            }
    }

    __device__ __forceinline__ void epi_res(const f32x4 (&acc)[2][2][4][2], const Unit& u, int wr, int wc, int fr, int fq) const {
        const int row0 = u.pm * BM + wr * 64 + fr;
        const int col0 = u.pn * BM + wc * 32 + 8 * fq;
#pragma unroll
        for (int ai = 0; ai < 2; ++ai) {
            u32x4 xo[4][2];
#pragma unroll
            for (int m = 0; m < 4; ++m)
#pragma unroll
                for (int bj = 0; bj < 2; ++bj) xo[m][bj] = *(const u32x4*)(xb + (size_t)(row0 + ai * HALF + m * 16) * 1024 + col0 + bj * HALF);
#pragma unroll
            for (int m = 0; m < 4; ++m) {
                const int row = row0 + ai * HALF + m * 16;
                float sq = 0.f;
#pragma unroll
                for (int bj = 0; bj < 2; ++bj) {
                    const u32x4 xw = xo[m][bj];
                    const f32x4 x0 = {__uint_as_float(xw.x << 16), __uint_as_float(xw.x & 0xffff0000u), __uint_as_float(xw.y << 16), __uint_as_float(xw.y & 0xffff0000u)};
                    const f32x4 x1 = {__uint_as_float(xw.z << 16), __uint_as_float(xw.z & 0xffff0000u), __uint_as_float(xw.w << 16), __uint_as_float(xw.w & 0xffff0000u)};
                    const f32x4 n0 = x0 + acc[ai][bj][m][0] * ascale, n1 = x1 + acc[ai][bj][m][1] * ascale;
                    u32x4 w; w.x = cvt_pk_bf16(n0[0], n0[1]); w.y = cvt_pk_bf16(n0[2], n0[3]); w.z = cvt_pk_bf16(n1[0], n1[1]); w.w = cvt_pk_bf16(n1[2], n1[3]);
                    *(u32x4*)(xb + (size_t)row * 1024 + col0 + bj * HALF) = w;
                    sq += ((n0[0] * n0[0] + n0[1] * n0[1]) + (n0[2] * n0[2] + n0[3] * n0[3])) + ((n1[0] * n1[0] + n1[1] * n1[1]) + (n1[2] * n1[2] + n1[3] * n1[3]));
                }
                sq += __shfl_xor(sq, 16); sq += __shfl_xor(sq, 32);
                if (fq == 0) __hip_atomic_fetch_add(ssn + row, (unsigned long long)(sq * SS_FIX), __ATOMIC_RELAXED, __HIP_MEMORY_SCOPE_AGENT);
            }
        }
    }

    __device__ __forceinline__ void epi_up(const f32x4 (&acc)[2][2][4][2], const Unit& u, int wr, int wc, int fr, int fq) const {
        const int row0 = u.pm * BM + wr * 64 + fr;
        const int col0 = u.pn * BM + wc * 32 + 8 * fq;
#pragma unroll
        for (int ai = 0; ai < 2; ++ai)
#pragma unroll
            for (int m = 0; m < 4; ++m) {
                const int row = row0 + ai * HALF + m * 16;
                const float rs = rsqrtf((float)ss[row] * SS_INV + 1e-6f);
#pragma unroll
                for (int bj = 0; bj < 2; ++bj) {
                    f32x4 v0 = acc[ai][bj][m][0] * rs, v1 = acc[ai][bj][m][1] * rs;
#pragma unroll
                    for (int j = 0; j < 4; ++j) { const float a = fmaxf(v0[j], 0.f), b = fmaxf(v1[j], 0.f); v0[j] = a * a; v1[j] = b * b; }
                    u32x4 w; w.x = cvt_pk_bf16(v0[0], v0[1]); w.y = cvt_pk_bf16(v0[2], v0[3]); w.z = cvt_pk_bf16(v1[0], v1[1]); w.w = cvt_pk_bf16(v1[2], v1[3]);
                    { const int col = col0 + bj * HALF;
                      *(u32x4*)(Z + ((size_t)((row >> 8) * 64 + (col >> 6)) * 256 + (row & 255)) * 64 + (col & 63)) = w; }
                }
            }
    }
};

template <class Epi, class Sched, bool ALIGN_EPI = false, bool SP2 = false>
__device__ __forceinline__ void gemm_phase(PG8_LAS unsigned char* lds, const Gemm g, const Sched& S, const Epi& E) {
    const int tid = threadIdx.x, wid = __builtin_amdgcn_readfirstlane(tid >> 6), lane = tid & 63, wr = wid >> 2, wc = wid & 3, fr = lane & 15, fq = lane >> 4;
    const int K = g.K, nt = K / BK;
    const int ldA = g.ablk ? BK : K;
    unsigned voffA[2], voffB[2];
#pragma unroll
    for (int i = 0; i < 2; ++i) { int R, C; stage_rc(tid * 16 + i * 8192, R, C); const int Rb = Epi::PERM ? ((R & ~31) + perm32(R & 31)) : R;
        voffA[i] = (unsigned)(R * ldA + C) * 2u; voffB[i] = (unsigned)(Rb * K + C) * 2u; }
    const size_t kstep = (size_t)(BK * 2);
    const size_t hstep = (size_t)HALF * K * 2;
    const size_t tstep = 2 * hstep;
    const size_t kstepA = g.ablk ? (size_t)BM * BK * 2 : kstep, hstepA = g.ablk ? (size_t)HALF * BK * 2 : hstep, tstepA = g.ablk ? (size_t)(K / BK) * BM * BK * 2 : tstep;
    const unsigned ldsw = (unsigned)wid * 1024u;
    const int aoff = lds_byte(wr * 64 + fr, fq * 8), boff = lds_byte(wc * 32 + fr, fq * 8);
#define PG8_SA(b, h) (((b) * 2 + (h)) * HTB)
#define PG8_SB(b, h) ((4 + (b) * 2 + (h)) * HTB)
#define PG8_STAGE(bufoff, gbase, voff) do { _Pragma("unroll") for (int _i = 0; _i < 2; ++_i) \
        __builtin_amdgcn_global_load_lds((const unsigned*)((const char*)(gbase) + (voff)[_i]), (PG8_LAS unsigned*)(lds + (bufoff) + ldsw + _i * 8192), 16, 0, 0); } while (0)
#define PG8_LDA(dst, b, h) do { _Pragma("unroll") for (int m = 0; m < 4; ++m) _Pragma("unroll") for (int k = 0; k < 2; ++k) dst[m][k] = *(const PG8_LAS bf16x8*)(lds + PG8_SA(b, h) + aoff + m * 2048 + k * 1024); } while (0)
#define PG8_LDB(dst, b, h) do { _Pragma("unroll") for (int n = 0; n < 2; ++n) _Pragma("unroll") for (int k = 0; k < 2; ++k) dst[n][k] = *(const PG8_LAS bf16x8*)(lds + PG8_SB(b, h) + boff + n * 2048 + k * 1024); } while (0)
#define PG8_MMA(ai, bj, At, Bt) do { __builtin_amdgcn_s_setprio(1); _Pragma("unroll") for (int m = 0; m < 4; ++m) _Pragma("unroll") for (int n = 0; n < 2; ++n) _Pragma("unroll") for (int k = 0; k < 2; ++k) \
        acc[ai][bj][m][n] = __builtin_amdgcn_mfma_f32_16x16x32_bf16(Bt[n][k], At[m][k], acc[ai][bj][m][n], 0, 0, 0); __builtin_amdgcn_s_setprio(0); } while (0)
#define PG8_WAIT_V(n) asm volatile("s_waitcnt vmcnt(" #n ")" ::: "memory")
#define PG8_WAIT_L(n) asm volatile("s_waitcnt lgkmcnt(" #n ")" ::: "memory")
#define PG8_BAR __builtin_amdgcn_s_barrier()
#define PG8_SCHED __builtin_amdgcn_sched_barrier(0)
    Unit cur, nxt; int ui = 0;
    if (!S.next(0, cur)) return;
    f32x4 acc[2][2][4][2];
#pragma unroll
    for (int a = 0; a < 2; ++a)
#pragma unroll
        for (int b = 0; b < 2; ++b)
#pragma unroll
            for (int m = 0; m < 4; ++m)
#pragma unroll
                for (int n = 0; n < 2; ++n) acc[a][b][m][n] = (f32x4){0.f, 0.f, 0.f, 0.f};
    bf16x8 At[4][2], B0[2][2], B1[2][2];
    const char* cA = (const char*)g.A + (size_t)cur.pm * tstepA; const char* cB = (const char*)g.Bt + (size_t)cur.pn * tstep;
    S.a_ready(cur);
    if constexpr (SP2) {
        PG8_STAGE(PG8_SB(0, 0), cB, voffB); PG8_STAGE(PG8_SB(0, 1), cB + hstep, voffB); PG8_STAGE(PG8_SA(0, 0), cA, voffA); PG8_STAGE(PG8_SA(0, 1), cA + hstepA, voffA);
        if (wr == 1) PG8_BAR;
        PG8_WAIT_V(2); PG8_BAR;
        PG8_STAGE(PG8_SB(1, 0), cB + kstep, voffB); PG8_STAGE(PG8_SA(1, 0), cA + kstepA, voffA); PG8_STAGE(PG8_SB(1, 1), cB + hstep + kstep, voffB);
        PG8_WAIT_V(6); PG8_BAR;
    } else {
        PG8_STAGE(PG8_SB(0, 0), cB, voffB); PG8_STAGE(PG8_SA(0, 0), cA, voffA); PG8_STAGE(PG8_SB(0, 1), cB + hstep, voffB); PG8_STAGE(PG8_SA(0, 1), cA + hstepA, voffA);
        if (wr == 1) PG8_BAR;
        PG8_WAIT_V(4); PG8_BAR;
        PG8_STAGE(PG8_SB(1, 0), cB + kstep, voffB); PG8_STAGE(PG8_SA(1, 0), cA + kstepA, voffA); PG8_STAGE(PG8_SB(1, 1), cB + hstep + kstep, voffB);
        PG8_WAIT_V(6); PG8_BAR;
    }
    for (;;) {
        const bool has_next = S.next(ui + 1, nxt);
        const char* nA = has_next ? (const char*)g.A + (size_t)nxt.pm * tstepA : cA; const char* nB = has_next ? (const char*)g.Bt + (size_t)nxt.pn * tstep : cB;
        for (int t = 0; t < nt; t += 2) {
            const bool last = (t == nt - 2);
            const char* a1 = cA + (size_t)(t + 1) * kstepA;
            const char* a2 = last ? nA : cA + (size_t)(t + 2) * kstepA; const char* b2 = last ? nB : cB + (size_t)(t + 2) * kstep;
            const char* a3 = a2 + kstepA; const char* b3 = b2 + kstep;
            if (last && has_next) S.a_ready(nxt);
            if constexpr (SP2) {
            PG8_LDB(B0, 0, 0); PG8_LDB(B1, 0, 1); PG8_SCHED; PG8_LDA(At, 0, 0); PG8_STAGE(PG8_SA(1, 1), a1 + hstepA, voffA);
            PG8_WAIT_V(8); PG8_WAIT_L(0); PG8_BAR; PG8_MMA(0, 0, At, B0); PG8_MMA(0, 1, At, B1); PG8_BAR; PG8_SCHED;
            PG8_LDA(At, 0, 1); PG8_STAGE(PG8_SB(0, 0), b2, voffB); PG8_STAGE(PG8_SB(0, 1), b2 + hstep, voffB); PG8_STAGE(PG8_SA(0, 0), a2, voffA);
            PG8_WAIT_V(8); PG8_WAIT_L(0); PG8_BAR; PG8_MMA(1, 0, At, B0); PG8_MMA(1, 1, At, B1); PG8_BAR; PG8_SCHED;
            PG8_LDB(B0, 1, 0); PG8_LDB(B1, 1, 1); PG8_SCHED; PG8_LDA(At, 1, 0); PG8_STAGE(PG8_SA(0, 1), a2 + hstepA, voffA);
            PG8_WAIT_V(8); PG8_WAIT_L(0); PG8_BAR; PG8_MMA(0, 0, At, B0); PG8_MMA(0, 1, At, B1); PG8_BAR; PG8_SCHED;
            PG8_LDA(At, 1, 1); PG8_STAGE(PG8_SB(1, 0), b3, voffB); PG8_STAGE(PG8_SB(1, 1), b3 + hstep, voffB); PG8_STAGE(PG8_SA(1, 0), a3, voffA);
            PG8_WAIT_V(8); PG8_WAIT_L(0); PG8_BAR; PG8_MMA(1, 0, At, B0); PG8_MMA(1, 1, At, B1); PG8_BAR; PG8_SCHED;
            } else {
            PG8_LDB(B0, 0, 0); PG8_SCHED; PG8_LDA(At, 0, 0); PG8_STAGE(PG8_SA(1, 1), a1 + hstepA, voffA);
            PG8_WAIT_L(8); PG8_BAR; PG8_WAIT_L(0); PG8_MMA(0, 0, At, B0); PG8_BAR; PG8_SCHED;
            PG8_LDB(B1, 0, 1); PG8_STAGE(PG8_SB(0, 0), b2, voffB);
            PG8_BAR; PG8_WAIT_L(0); PG8_MMA(0, 1, At, B1); PG8_BAR;
            PG8_LDA(At, 0, 1); PG8_STAGE(PG8_SA(0, 0), a2, voffA);
            PG8_BAR; PG8_WAIT_L(0); PG8_MMA(1, 0, At, B0); PG8_BAR; PG8_SCHED;
            PG8_STAGE(PG8_SB(0, 1), b2 + hstep, voffB);
            PG8_WAIT_V(6); PG8_BAR; PG8_MMA(1, 1, At, B1); PG8_BAR;
            PG8_LDB(B0, 1, 0); PG8_SCHED; PG8_LDA(At, 1, 0); PG8_STAGE(PG8_SA(0, 1), a2 + hstepA, voffA);
            PG8_WAIT_L(8); PG8_BAR; PG8_WAIT_L(0); PG8_MMA(0, 0, At, B0); PG8_BAR; PG8_SCHED;
            PG8_LDB(B1, 1, 1); PG8_STAGE(PG8_SB(1, 0), b3, voffB);
            PG8_BAR; PG8_WAIT_L(0); PG8_MMA(0, 1, At, B1); PG8_BAR;
            PG8_LDA(At, 1, 1); PG8_STAGE(PG8_SA(1, 0), a3, voffA);
            PG8_BAR; PG8_WAIT_L(0); PG8_MMA(1, 0, At, B0); PG8_BAR; PG8_SCHED;
            PG8_STAGE(PG8_SB(1, 1), b3 + hstep, voffB);
            PG8_WAIT_V(6); PG8_BAR; PG8_MMA(1, 1, At, B1); PG8_BAR;
            }
        }
        if constexpr (ALIGN_EPI) { if (wr == 0) PG8_BAR; }
        if constexpr (!Epi::AFTER_DRAIN) { E(acc, cur, wr, wc, fr, fq); S.done(cur); }
        if (!has_next) break;
#pragma unroll
        for (int a = 0; a < 2; ++a)
#pragma unroll
            for (int b = 0; b < 2; ++b)
#pragma unroll
                for (int m = 0; m < 4; ++m)
#pragma unroll
                    for (int n = 0; n < 2; ++n) acc[a][b][m][n] = (f32x4){0.f, 0.f, 0.f, 0.f};
        cur = nxt; cA = nA; cB = nB; ++ui;
        if constexpr (ALIGN_EPI) { if (wr == 1) PG8_BAR; }
    }
    PG8_WAIT_V(0);
    if constexpr (!ALIGN_EPI) { if (wr == 0) PG8_BAR; }
    PG8_BAR;
    if constexpr (Epi::AFTER_DRAIN) { E.fused(acc, cur, wr, wc, fr, fq, lds, wid, lane); S.done(cur); }
#undef PG8_SA
#undef PG8_SB
#undef PG8_STAGE
#undef PG8_LDA
#undef PG8_LDB
#undef PG8_MMA
#undef PG8_WAIT_V
#undef PG8_WAIT_L
#undef PG8_BAR
#undef PG8_SCHED
}
}
#define LAS __attribute__((address_space(3)))
typedef LAS unsigned char* ldsp;
typedef unsigned short bf16_t;
typedef short bf16x8 __attribute__((ext_vector_type(8)));
typedef short s16x4 __attribute__((ext_vector_type(4)));
typedef float f32x4 __attribute__((ext_vector_type(4)));
typedef float f32x16 __attribute__((ext_vector_type(16)));
typedef unsigned u32x4 __attribute__((ext_vector_type(4)));
typedef unsigned u32x2 __attribute__((ext_vector_type(2)));
typedef float f32x2_t __attribute__((ext_vector_type(2)));
typedef __bf16 bf16x2_t __attribute__((ext_vector_type(2)));

constexpr int M_TOK = 32768, SEQL = 4096, DM = 1024, INC = 3584, FF = 4096, ZP = 3072, DEPTH = 4;
constexpr int NWAVES = 8, NTHR = 512;
constexpr size_t MiB = 1u << 20;
constexpr size_t WS_CTL = 0;
constexpr size_t WS_SS = 1 * MiB;
constexpr size_t WS_W = 4 * MiB;
constexpr size_t W_LAYER = 25 * MiB, W_IN = 0, W_OUT = 7 * MiB, W_UP = 9 * MiB, W_DOWN = 17 * MiB;
constexpr size_t WS_XB = 104 * MiB;
constexpr size_t WS_Z = 168 * MiB;
constexpr size_t WS_G = 360 * MiB;
constexpr size_t WS_U = 168 * MiB;
constexpr size_t WS_MIX = 424 * MiB;
constexpr size_t WS_SC = 488 * MiB;
constexpr size_t WS_END = 490 * MiB;
constexpr int CW_QCTR = 8192;
constexpr int CW_LAM = 1024;
constexpr int CW_LB = 2048;
constexpr int CW_BAR = 4096;
constexpr size_t CTL_ZERO_BYTES = 65536;
constexpr int LDS_BYTES = 147456;
constexpr float LOG2E = 1.4426950408889634f;

__device__ __forceinline__ unsigned cvtpk(float lo, float hi) { f32x2_t v = {lo, hi}; bf16x2_t b = __builtin_convertvector(v, bf16x2_t); return __builtin_bit_cast(unsigned, b); }
__device__ __forceinline__ float bf2f(unsigned short u) { return __uint_as_float((unsigned)u << 16); }
__device__ __forceinline__ int crow(int reg, int h) { return (reg & 3) + 8 * (reg >> 2) + 4 * h; }
__device__ __forceinline__ float wave_sum(float v) {
#pragma unroll
    for (int o = 1; o < 64; o <<= 1) v += __shfl_xor(v, o);
    return v;
}
#define MFMA32(a, b, c) __builtin_amdgcn_mfma_f32_32x32x16_bf16((a), (b), (c), 0, 0, 0)
__device__ __forceinline__ bf16x8 pack_step(const f32x16& x, int s) {
    u32x4 p; p.x = cvtpk(x[8 * s], x[8 * s + 1]); p.y = cvtpk(x[8 * s + 2], x[8 * s + 3]); p.z = cvtpk(x[8 * s + 4], x[8 * s + 5]); p.w = cvtpk(x[8 * s + 6], x[8 * s + 7]);
    return __builtin_bit_cast(bf16x8, p);
}
typedef short v4i16_t __attribute__((ext_vector_type(4)));
__device__ __forceinline__ s16x4 vtr(ldsp p) { return __builtin_bit_cast(s16x4, __builtin_amdgcn_ds_read_tr16_b64_v4i16((LAS v4i16_t*)p)); }

struct P0Item { const float* W; const float* gk; bf16_t* WT; int K, N, k0, n0; };
__device__ __forceinline__ void p0_load(const P0Item& d, int lane, f32x4 (&wv)[8], float (&gg)[8]) {
    const int kr = lane >> 3, nq = (lane & 7) * 4;
#pragma unroll
    for (int i = 0; i < 8; ++i) { const int kk = 8 * i + kr; wv[i] = __builtin_nontemporal_load((const f32x4*)(d.W + (size_t)(d.k0 + kk) * d.N + d.n0 + nq));     gg[i] = d.gk ? d.gk[d.k0 + kk] : 1.0f; }
}
__device__ __forceinline__ void p0_store(const P0Item& d, int lane, LAS float* scr, const f32x4 (&wv)[8], const float (&gg)[8]) {
    const int kr = lane >> 3, nq = (lane & 7) * 4;
#pragma unroll
    for (int i = 0; i < 8; ++i) { const int kk = 8 * i + kr;
#pragma unroll
        for (int j = 0; j < 4; ++j) scr[kk * 33 + nq + j] = wv[i][j] * gg[i]; }
    asm volatile("s_waitcnt lgkmcnt(0)" ::: "memory");
    const int c = lane & 7;
#pragma unroll
    for (int j = 0; j < 4; ++j) { const int n = (lane >> 3) + 8 * j; const LAS float* sp = scr + (8 * c) * 33 + n;
        u32x4 o; o.x = cvtpk(sp[0 * 33], sp[1 * 33]); o.y = cvtpk(sp[2 * 33], sp[3 * 33]); o.z = cvtpk(sp[4 * 33], sp[5 * 33]); o.w = cvtpk(sp[6 * 33], sp[7 * 33]);
        *(u32x4*)(d.WT + (size_t)(d.n0 + n) * d.K + d.k0 + 8 * c) = o; }
    asm volatile("s_waitcnt lgkmcnt(0)" ::: "memory");
}

struct Args { const float* in[13]; float* out; unsigned char* ws; };
__device__ __forceinline__ P0Item p0_decode(const Args& args, unsigned char* ws, int it) {
    constexpr int I_IN = (DM / 64) * (INC / 32), I_OUT = (DM / 64) * (DM / 32), I_UP = (DM / 64) * (FF / 32), I_DN = (FF / 64) * (DM / 32), I_L = I_IN + I_OUT + I_UP + I_DN;
    const int l = it / I_L; int rr = it % I_L;
    unsigned char* wl = ws + WS_W + (size_t)l * W_LAYER;
    P0Item d;
    if (rr < I_IN) { d.W = args.in[2] + (size_t)l * DM * INC; d.gk = args.in[1] + l * DM; d.WT = (bf16_t*)(wl + W_IN); d.K = DM; d.N = INC; }
    else if ((rr -= I_IN) < I_OUT) { d.W = args.in[7] + (size_t)l * DM * DM; d.gk = nullptr; d.WT = (bf16_t*)(wl + W_OUT); d.K = DM; d.N = DM; }
    else if ((rr -= I_OUT) < I_UP) { d.W = args.in[9] + (size_t)l * DM * FF; d.gk = args.in[8] + l * DM; d.WT = (bf16_t*)(wl + W_UP); d.K = DM; d.N = FF; }
    else { rr -= I_UP; d.W = args.in[10] + (size_t)l * FF * DM; d.gk = nullptr; d.WT = (bf16_t*)(wl + W_DOWN); d.K = FF; d.N = DM; }
    const int nblk = d.N / 32; d.k0 = 64 * (rr / nblk); d.n0 = 32 * (rr % nblk);
    return d;
}


constexpr int AT_KP = 272, AT_VP = 320, AT_KB = 64 * AT_KP, AT_VB = 64 * AT_VP;
constexpr int AT_K0 = 0, AT_V0 = 2 * AT_KB, AT_BIAS = AT_V0 + 2 * AT_VB, AT_EX = 0;
static_assert(AT_BIAS >= 65536 && AT_BIAS + 4096 <= LDS_BYTES - 32, "attention LDS map");
__device__ __forceinline__ void attn_bias_tables(ldsp lds, const float* relb) {
    for (int e = threadIdx.x; e < 1024; e += NTHR) {
        const int h = e >> 8, rel = (e & 255) - 192, n = rel < 0 ? -rel : rel;
        int bk = rel > 0 ? 16 : 0;
        if (n < 8) bk += n;
        else { int lg = 8 + (int)(2.0f * __log2f((float)n * 0.125f) + 1e-4f); bk += lg < 15 ? lg : 15; }
        *(LAS float*)(lds + AT_BIAS + 4 * e) = (relb[bk * 4 + h] - relb[15 * 4 + h]) * LOG2E;
    }
}

template <int PB>
__device__ __forceinline__ void attn_unit(ldsp lds, int b, int h, int qb, const bf16_t* Z, bf16_t* MIX, const float* relb, const float* gnorm, float lam, float oscale) {
    int tid = threadIdx.x; asm volatile("" : "+v"(tid));
    const int lane = tid & 63, w = __builtin_amdgcn_readfirstlane(tid >> 6), r = lane & 31, hh = lane >> 5, i16 = lane & 15;
    const int wq = w & 3, map = w >> 2;
    const int rowbase = b * SEQL, q0 = qb * 128, qw = q0 + 32 * wq, ntiles = 2 * qb + 2, my_last = qw >> 6;
    bf16x8 qf[4];
    { const bf16_t* qp = Z + (size_t)(rowbase + qw + r) * ZP + h * 128 + map * 64 + 8 * hh;
#pragma unroll
      for (int d0 = 0; d0 < 4; ++d0) qf[d0] = *(const bf16x8*)(qp + 16 * d0); }
    const int srow0 = tid >> 4, scc = tid & 15;
    const bf16_t* kg = Z + (size_t)rowbase * ZP + 512 + h * 128 + scc * 8;
    const bf16_t* vg = Z + (size_t)rowbase * ZP + 1024 + h * 128 + scc * 8;
    u32x4 kr[2], vr[2];
#define AT_LOAD(kt) do { _Pragma("unroll") for (int i_ = 0; i_ < 2; ++i_) { const size_t ro_ = (size_t)((kt) * 64 + srow0 + 32 * i_) * ZP; kr[i_] = *(const u32x4*)(kg + ro_); vr[i_] = *(const u32x4*)(vg + ro_); } } while (0)
#define AT_STORE(buf) do { _Pragma("unroll") for (int i_ = 0; i_ < 2; ++i_) { const int row_ = srow0 + 32 * i_; \
        *(LAS u32x4*)(lds + AT_K0 + (buf) * AT_KB + row_ * AT_KP + scc * 16) = kr[i_]; *(LAS u32x4*)(lds + AT_V0 + (buf) * AT_VB + row_ * AT_VP + scc * 16) = vr[i_]; } } while (0)
    AT_LOAD(0); AT_STORE(0);
    __syncthreads();
    float mrun = 0.f, lrun = 0.f;
    f32x16 o[4], negm;
#pragma unroll
    for (int j = 0; j < 16; ++j) negm[j] = 0.f;
#pragma unroll
    for (int i = 0; i < 4; ++i)
#pragma unroll
        for (int j = 0; j < 16; ++j) o[i][j] = 0.f;
    for (int kt = 0; kt < ntiles; ++kt) {
        const bool more = (kt + 1 < ntiles);
        if (more && !(PB & 8)) AT_LOAD(kt + 1);
        if (kt <= my_last) {
            const ldsp Kb = lds + AT_K0 + (kt & 1) * AT_KB + r * AT_KP + (map * 64 + 8 * hh) * 2;
            const ldsp Vb = lds + AT_V0 + (kt & 1) * AT_VB + (4 * hh + (i16 >> 2)) * AT_VP + (16 * ((lane >> 4) & 1) + 4 * (i16 & 3)) * 2;
            f32x16 s0, s1;
#pragma unroll
            for (int d0 = 0; d0 < 4; ++d0) {
                const bf16x8 k0f = *(const LAS bf16x8*)(Kb + d0 * 32), k1f = *(const LAS bf16x8*)(Kb + 32 * AT_KP + d0 * 32);
                if (d0 == 0) { s0 = MFMA32(k0f, qf[0], negm); s1 = MFMA32(k1f, qf[0], negm); }
                else { s0 = MFMA32(k0f, qf[d0], s0); s1 = MFMA32(k1f, qf[d0], s1); }
            }
            if (64 * kt + 153 >= qw) {
                const int base = 64 * kt - (qw + r) + 192 + 4 * hh;
#pragma unroll
                for (int j = 0; j < 16; ++j) { int i0 = base + (j & 3) + 8 * (j >> 2); int i1 = i0 + 32; i0 = i0 < 0 ? 0 : i0; i1 = i1 < 0 ? 0 : i1;
                    s0[j] += *(const LAS float*)(lds + AT_BIAS + h * 1024 + 4 * i0); s1[j] += *(const LAS float*)(lds + AT_BIAS + h * 1024 + 4 * i1); }
            }
            if (!(PB & 4)) {
            float tmax = fmaxf(s0[0], s1[0]);
#pragma unroll
            for (int j = 1; j < 16; ++j) tmax = fmaxf(tmax, fmaxf(s0[j], s1[j]));
            tmax = fmaxf(tmax, __shfl_xor(tmax, 32));
            if (kt == 0 || __any(tmax > 8.0f)) {
                const float dl = (kt == 0) ? tmax : fmaxf(tmax, 0.f);
                const float alpha = (kt == 0) ? 1.0f : __builtin_amdgcn_exp2f(-dl);
                mrun += dl; lrun *= alpha;
#pragma unroll
                for (int j = 0; j < 16; ++j) negm[j] = -mrun;
#pragma unroll
                for (int j = 0; j < 16; ++j) { s0[j] -= dl; s1[j] -= dl; }
#pragma unroll
                for (int i = 0; i < 4; ++i)
#pragma unroll
                    for (int j = 0; j < 16; ++j) o[i][j] *= alpha;
            }
            float ls = 0.f;
#pragma unroll
            for (int j = 0; j < 16; ++j) { s0[j] = __builtin_amdgcn_exp2f(s0[j]); s1[j] = __builtin_amdgcn_exp2f(s1[j]); ls += s0[j] + s1[j]; }
            lrun += ls;
            }
            if (!(PB & 2))
#pragma unroll
            for (int sub = 0; sub < 2; ++sub)
#pragma unroll
                for (int st = 0; st < 2; ++st) {
                    const bf16x8 pf = pack_step(sub ? s1 : s0, st);
                    const ldsp vp = Vb + (32 * sub + 16 * st) * AT_VP;
#pragma unroll
                    for (int blk = 0; blk < 4; ++blk) {
                        const s16x4 lo = vtr(vp + blk * 64), hi = vtr(vp + 8 * AT_VP + blk * 64);
                        const bf16x8 vf = __builtin_shufflevector(lo, hi, 0, 1, 2, 3, 4, 5, 6, 7);
                        o[blk] = MFMA32(vf, pf, o[blk]);
                    }
                }
        }
        if (more && !(PB & 8)) AT_STORE((kt + 1) & 1);
        __syncthreads();
    }
#undef AT_LOAD
#undef AT_STORE
    { const float lt = lrun + __shfl_xor(lrun, 32); const float inv = 1.0f / lt;
#pragma unroll
      for (int i = 0; i < 4; ++i)
#pragma unroll
          for (int j = 0; j < 16; ++j) o[i][j] *= inv; }
    const ldsp ex = lds + AT_EX + wq * 16384 + lane * 4;
    if (map == 1) {
#pragma unroll
        for (int i = 0; i < 4; ++i)
#pragma unroll
            for (int j = 0; j < 16; ++j) *(LAS float*)(ex + (i * 16 + j) * 256) = o[i][j];
    }
    __syncthreads();
    if (map == 0 && !(PB & 1)) {
        float sq = 0.f;
#pragma unroll
        for (int i = 0; i < 4; ++i)
#pragma unroll
            for (int j = 0; j < 16; ++j) { const float d = o[i][j] - lam * *(const LAS float*)(ex + (i * 16 + j) * 256); o[i][j] = d; sq += d * d; }
        sq += __shfl_xor(sq, 32);
        const float rs = rsqrtf(sq * (1.0f / 128.0f) + 1e-6f) * oscale;
        bf16_t* op = MIX + (size_t)(rowbase + qw + r) * DM + h * 128 + 4 * hh;
#pragma unroll
        for (int i = 0; i < 4; ++i)
#pragma unroll
            for (int g4 = 0; g4 < 4; ++g4) {
                const int vd = 32 * i + 8 * g4;
                const f32x4 gn = *(const f32x4*)(gnorm + vd + 4 * hh);
                u32x2 wv; wv.x = cvtpk(o[i][4 * g4] * rs * gn[0], o[i][4 * g4 + 1] * rs * gn[1]); wv.y = cvtpk(o[i][4 * g4 + 2] * rs * gn[2], o[i][4 * g4 + 3] * rs * gn[3]);
                *(u32x2*)(op + vd) = wv;
            }
    }
    __syncthreads();
}

constexpr int HG_P = 272, HG_PT = 144;
constexpr int HG_QH = 0, HG_KH = 64 * HG_P, HG_KHT = 2 * 64 * HG_P, HG_VT = HG_KHT + 128 * HG_PT, HG_SS = HG_VT + 128 * HG_PT, HG_TOT = HG_SS + 128 * HG_P;
constexpr int HG_E2 = HG_TOT + 4096, HG_SSQ = HG_E2 + 512, HG_END = HG_SSQ + 1024;
static_assert(HG_END <= LDS_BYTES - 16, "hgrn LDS map");

template <int MODE>
__device__ __forceinline__ void hgrn_chunk(ldsp lds, int u0, int ustride, const bf16_t* Z, const _Float16* G, bf16_t* TS, float* SC, bf16_t* MIX, const float* gnorm, int lite = 0) {
    int tid = threadIdx.x; asm volatile("" : "+v"(tid));
    const int lane = tid & 63, w = __builtin_amdgcn_readfirstlane(tid >> 6), r = lane & 31, hh = lane >> 5;
    const int kp = (tid & 63) * 2, part = tid >> 6;
    const int vb = w >> 1, tb = w & 1;
    unsigned gr2[8], qr2[8], vr2[8]; u32x4 ssr[4];
#define HG_LOAD(uu) do { const int bh_ = (uu) >> 6, c_ = (uu) & 63, b_ = bh_ >> 2, h_ = bh_ & 3; const size_t r0_ = (size_t)b_ * SEQL + (size_t)c_ * 64 + 8 * part; \
      const unsigned* gp_ = (const unsigned*)(G + r0_ * 512 + h_ * 128 + kp); const unsigned* qp_ = (const unsigned*)(Z + r0_ * ZP + 1536 + h_ * 128 + kp); const unsigned* vp_ = (const unsigned*)(Z + r0_ * ZP + 2048 + h_ * 128 + kp); \
      _Pragma("unroll") for (int i_ = 0; i_ < 8; ++i_) { gr2[i_] = gp_[(size_t)i_ * 256]; vr2[i_] = vp_[(size_t)i_ * (ZP / 2)]; if (MODE == 3) qr2[i_] = qp_[(size_t)i_ * (ZP / 2)]; else qr2[i_] = 0; } \
      if (MODE == 3) { const bf16_t* sl_ = TS + (size_t)(uu) * 16384; _Pragma("unroll") for (int i_ = 0; i_ < 4; ++i_) { const int cid_ = tid + 512 * i_; ssr[i_] = *(const u32x4*)(sl_ + (cid_ >> 4) * 128 + (cid_ & 15) * 8); } } } while (0)
    if (u0 < 2048) HG_LOAD(u0);
#pragma unroll 1
    for (int u = u0; u < 2048; u += ustride) {
    const int bh = u >> 6, c = u & 63, b = bh >> 2, h = bh & 3;
    const size_t row0 = (size_t)b * SEQL + (size_t)c * 64;
    bf16_t* slot = TS + (size_t)u * 16384;
    float g0[8], g1[8], cs0[8], cs1[8];
    { float a0 = 0.f, a1 = 0.f;
#pragma unroll
      for (int i = 0; i < 8; ++i) { g0[i] = (float)__builtin_bit_cast(_Float16, (unsigned short)(gr2[i] & 0xffffu)); g1[i] = (float)__builtin_bit_cast(_Float16, (unsigned short)(gr2[i] >> 16));
          a0 += g0[i]; a1 += g1[i]; cs0[i] = a0; cs1[i] = a1; } }
    *(LAS f32x2_t*)(lds + HG_TOT + (part * 128 + kp) * 4) = (f32x2_t){cs0[7], cs1[7]};
    __syncthreads();
    { float off0 = 0.f, off1 = 0.f, rho0 = 0.f, rho1 = 0.f, bl0 = 0.f, bl1 = 0.f;
#pragma unroll
      for (int p = 0; p < 8; ++p) { const f32x2_t tt = *(const LAS f32x2_t*)(lds + HG_TOT + (p * 128 + kp) * 4);
          if (p < part) { off0 += tt.x; off1 += tt.y; }
          if (p < 4) { rho0 += tt.x; rho1 += tt.y; }
          bl0 += tt.x; bl1 += tt.y; }
      unsigned kA[4], kB[4], vA[4], vB[4];
#pragma unroll
      for (int i = 0; i < 8; i += 2) {
          const int t = 8 * part + i;
          const float b00 = off0 + cs0[i], b01 = off1 + cs1[i], b10 = off0 + cs0[i + 1], b11 = off1 + cs1[i + 1];
          const float k00 = (1.0f - __expf(g0[i])) * __expf(rho0 - b00), k01 = (1.0f - __expf(g1[i])) * __expf(rho1 - b01);
          const float k10 = (1.0f - __expf(g0[i + 1])) * __expf(rho0 - b10), k11 = (1.0f - __expf(g1[i + 1])) * __expf(rho1 - b11);
          if (MODE == 3) {
              const float q00 = __uint_as_float(qr2[i] << 16) * __expf(b00 - rho0), q01 = __uint_as_float(qr2[i] & 0xffff0000u) * __expf(b01 - rho1);
              const float q10 = __uint_as_float(qr2[i + 1] << 16) * __expf(b10 - rho0), q11 = __uint_as_float(qr2[i + 1] & 0xffff0000u) * __expf(b11 - rho1);
              *(LAS unsigned*)(lds + HG_QH + t * HG_P + kp * 2) = cvtpk(q00, q01);
              *(LAS unsigned*)(lds + HG_QH + (t + 1) * HG_P + kp * 2) = cvtpk(q10, q11);
              *(LAS unsigned*)(lds + HG_KH + t * HG_P + kp * 2) = cvtpk(k00, k01);
              *(LAS unsigned*)(lds + HG_KH + (t + 1) * HG_P + kp * 2) = cvtpk(k10, k11);
          }
          kA[i >> 1] = cvtpk(k00, k10); kB[i >> 1] = cvtpk(k01, k11);
          vA[i >> 1] = (vr2[i] & 0xffffu) | (vr2[i + 1] << 16); vB[i >> 1] = (vr2[i] >> 16) | (vr2[i + 1] & 0xffff0000u);
      }
      if (MODE == 1) {
          *(LAS u32x4*)(lds + HG_KHT + kp * HG_PT + part * 16) = (u32x4){kA[0], kA[1], kA[2], kA[3]};
          *(LAS u32x4*)(lds + HG_KHT + (kp + 1) * HG_PT + part * 16) = (u32x4){kB[0], kB[1], kB[2], kB[3]};
      }
      *(LAS u32x4*)(lds + HG_VT + kp * HG_PT + part * 16) = (u32x4){vA[0], vA[1], vA[2], vA[3]};
      *(LAS u32x4*)(lds + HG_VT + (kp + 1) * HG_PT + part * 16) = (u32x4){vB[0], vB[1], vB[2], vB[3]};
      if (MODE == 1 && part == 0) {
          *(LAS f32x2_t*)(lds + HG_E2 + kp * 4) = (f32x2_t){__expf(bl0 - rho0), __expf(bl1 - rho1)};
          *(f32x2_t*)(SC + (size_t)u * 256 + kp) = (f32x2_t){__expf(bl0), __expf(bl1)};
          *(f32x2_t*)(SC + (size_t)u * 256 + 128 + kp) = (f32x2_t){__expf(rho0), __expf(rho1)};
      }
      if (MODE == 3) {
#pragma unroll
          for (int i = 0; i < 4; ++i) { const int cid = tid + 512 * i; *(LAS u32x4*)(lds + HG_SS + (cid >> 4) * HG_P + (cid & 15) * 16) = ssr[i]; }
      }
    }
    __syncthreads();
    if (u + ustride < 2048) HG_LOAD(u + ustride);
    u32x2 gtr[4];
    if (MODE == 3) {
        const size_t grow = row0 + 32 * tb + r;
#pragma unroll
        for (int g4 = 0; g4 < 4; ++g4) gtr[g4] = *(const u32x2*)(Z + grow * ZP + 2560 + h * 128 + 32 * vb + 8 * g4 + 4 * hh);
    }
    if (lite) {
    } else if (MODE == 1) {
#pragma unroll
        for (int i = 0; i < 2; ++i) {
            const int kb = 2 * tb + i;
            f32x16 T;
#pragma unroll
            for (int j = 0; j < 16; ++j) T[j] = 0.f;
#pragma unroll
            for (int s = 0; s < 4; ++s) {
                const bf16x8 af = *(const LAS bf16x8*)(lds + HG_VT + (32 * vb + r) * HG_PT + (16 * s + 8 * hh) * 2);
                const bf16x8 bfr = *(const LAS bf16x8*)(lds + HG_KHT + (32 * kb + r) * HG_PT + (16 * s + 8 * hh) * 2);
                T = MFMA32(af, bfr, T);
            }
            const float e2 = *(const LAS float*)(lds + HG_E2 + (32 * kb + r) * 4);
#pragma unroll
            for (int j = 0; j < 16; ++j) {
                const unsigned pk = cvtpk(T[j] * e2, 0.f);
                slot[(32 * vb + crow(j, hh)) * 128 + 32 * kb + r] = (unsigned short)(pk & 0xffffu);
            }
        }
    } else {
        bf16x8 qf[8];
#pragma unroll
        for (int s = 0; s < 8; ++s) qf[s] = *(const LAS bf16x8*)(lds + HG_QH + (32 * tb + r) * HG_P + (16 * s + 8 * hh) * 2);
        f32x16 at0, at1, out;
#pragma unroll
        for (int j = 0; j < 16; ++j) { at0[j] = 0.f; at1[j] = 0.f; out[j] = 0.f; }
#pragma unroll
        for (int s = 0; s < 8; ++s) { const bf16x8 kf = *(const LAS bf16x8*)(lds + HG_KH + r * HG_P + (16 * s + 8 * hh) * 2); at0 = MFMA32(kf, qf[s], at0); }
        if (tb == 1) {
#pragma unroll
            for (int s = 0; s < 8; ++s) { const bf16x8 kf = *(const LAS bf16x8*)(lds + HG_KH + (32 + r) * HG_P + (16 * s + 8 * hh) * 2); at1 = MFMA32(kf, qf[s], at1); }
#pragma unroll
            for (int j = 0; j < 16; ++j) if (crow(j, hh) > r) at1[j] = 0.f;
        } else {
#pragma unroll
            for (int j = 0; j < 16; ++j) if (crow(j, hh) > r) at0[j] = 0.f;
        }
        { const ldsp vtp = lds + HG_VT + (32 * vb + r) * HG_PT + 8 * hh;
#pragma unroll
          for (int s2 = 0; s2 < 2; ++s2) {
              const bf16x8 pf = pack_step(at0, s2);
              const s16x4 lo = *(const LAS s16x4*)(vtp + 32 * s2), hi = *(const LAS s16x4*)(vtp + 32 * s2 + 16);
              out = MFMA32(__builtin_shufflevector(lo, hi, 0, 1, 2, 3, 4, 5, 6, 7), pf, out);
          }
          if (tb == 1) {
#pragma unroll
              for (int s2 = 0; s2 < 2; ++s2) {
                  const bf16x8 pf = pack_step(at1, s2);
                  const s16x4 lo = *(const LAS s16x4*)(vtp + 64 + 32 * s2), hi = *(const LAS s16x4*)(vtp + 64 + 32 * s2 + 16);
                  out = MFMA32(__builtin_shufflevector(lo, hi, 0, 1, 2, 3, 4, 5, 6, 7), pf, out);
              }
          } }
#pragma unroll
        for (int s = 0; s < 8; ++s) { const bf16x8 sf = *(const LAS bf16x8*)(lds + HG_SS + (32 * vb + r) * HG_P + (16 * s + 8 * hh) * 2); out = MFMA32(sf, qf[s], out); }
        { float sq = 0.f;
#pragma unroll
          for (int j = 0; j < 16; ++j) sq += out[j] * out[j];
          sq += __shfl_xor(sq, 32);
          if (hh == 0) *(LAS float*)(lds + HG_SSQ + (vb * 64 + 32 * tb + r) * 4) = sq; }
        __syncthreads();
        { const int tl = 32 * tb + r;
          const float tot = (*(const LAS float*)(lds + HG_SSQ + tl * 4) + *(const LAS float*)(lds + HG_SSQ + (64 + tl) * 4)) + (*(const LAS float*)(lds + HG_SSQ + (128 + tl) * 4) + *(const LAS float*)(lds + HG_SSQ + (192 + tl) * 4));
          const float rs = rsqrtf(tot * (1.0f / 128.0f) + 1e-6f);
          const size_t row = row0 + tl;
#pragma unroll
          for (int g4 = 0; g4 < 4; ++g4) {
              const int v0 = 32 * vb + 8 * g4 + 4 * hh;
              const u32x2 gt = gtr[g4];
              const f32x4 gn = *(const f32x4*)(gnorm + v0);
              const float a0 = out[4 * g4] * rs * gn[0] * __uint_as_float(gt.x << 16), a1 = out[4 * g4 + 1] * rs * gn[1] * __uint_as_float(gt.x & 0xffff0000u);
              const float a2 = out[4 * g4 + 2] * rs * gn[2] * __uint_as_float(gt.y << 16), a3 = out[4 * g4 + 3] * rs * gn[3] * __uint_as_float(gt.y & 0xffff0000u);
              u32x2 wv; wv.x = cvtpk(a0, a1); wv.y = cvtpk(a2, a3);
              *(u32x2*)(MIX + row * DM + 512 + h * 128 + v0) = wv;
          } }
    }
    __syncthreads();
    }
#undef HG_LOAD
}

__device__ __forceinline__ void hgrn_scan(int bh, bf16_t* TS, const float* SC) {
    int tid = threadIdx.x; asm volatile("" : "+v"(tid));
    const int k8 = (tid & 15) * 8, v0 = tid >> 4;
    float S[4][8];
#pragma unroll
    for (int i = 0; i < 4; ++i)
#pragma unroll
        for (int j = 0; j < 8; ++j) S[i][j] = 0.f;
    bf16_t* base = TS + (size_t)bh * 64 * 16384 + (size_t)v0 * 128 + k8;
    const float* scb = SC + (size_t)bh * 64 * 256 + k8;
    u32x4 Tr[4][4]; f32x4 dlr[4][2], err[4][2];
#define HS_LOAD(d, c) do { _Pragma("unroll") for (int i_ = 0; i_ < 4; ++i_) Tr[d][i_] = __builtin_nontemporal_load((const u32x4*)(base + (size_t)(c) * 16384 + i_ * 32 * 128)); \
        dlr[d][0] = __builtin_nontemporal_load((const f32x4*)(scb + (size_t)(c) * 256)); dlr[d][1] = __builtin_nontemporal_load((const f32x4*)(scb + (size_t)(c) * 256 + 4)); \
        err[d][0] = __builtin_nontemporal_load((const f32x4*)(scb + (size_t)(c) * 256 + 128)); err[d][1] = __builtin_nontemporal_load((const f32x4*)(scb + (size_t)(c) * 256 + 132)); } while (0)
#pragma unroll
    for (int d = 0; d < 4; ++d) HS_LOAD(d, d);
#pragma unroll 1
    for (int c0 = 0; c0 < 64; c0 += 4) {
#pragma unroll
        for (int d = 0; d < 4; ++d) {
            const int c = c0 + d;
            float dl[8], er[8];
#pragma unroll
            for (int j = 0; j < 4; ++j) { dl[j] = dlr[d][0][j]; dl[4 + j] = dlr[d][1][j]; er[j] = err[d][0][j]; er[4 + j] = err[d][1][j]; }
#pragma unroll
            for (int i = 0; i < 4; ++i) {
                const u32x4 t = Tr[d][i];
                u32x4 o; o.x = cvtpk(S[i][0] * er[0], S[i][1] * er[1]); o.y = cvtpk(S[i][2] * er[2], S[i][3] * er[3]); o.z = cvtpk(S[i][4] * er[4], S[i][5] * er[5]); o.w = cvtpk(S[i][6] * er[6], S[i][7] * er[7]);
                S[i][0] = S[i][0] * dl[0] + __uint_as_float(t.x << 16); S[i][1] = S[i][1] * dl[1] + __uint_as_float(t.x & 0xffff0000u);
                S[i][2] = S[i][2] * dl[2] + __uint_as_float(t.y << 16); S[i][3] = S[i][3] * dl[3] + __uint_as_float(t.y & 0xffff0000u);
                S[i][4] = S[i][4] * dl[4] + __uint_as_float(t.z << 16); S[i][5] = S[i][5] * dl[5] + __uint_as_float(t.z & 0xffff0000u);
                S[i][6] = S[i][6] * dl[6] + __uint_as_float(t.w << 16); S[i][7] = S[i][7] * dl[7] + __uint_as_float(t.w & 0xffff0000u);
                *(u32x4*)(base + (size_t)c * 16384 + i * 32 * 128) = o;
            }
            if (c + 4 < 64) HS_LOAD(d, c + 4);
        }
    }
#undef HS_LOAD
}


#define XB_TMO      128
#define XB_XCNT(j)  (256  + 64 * (j))
#define XB_XSUB(j)  (1280 + 64 * (j))
#define XB_XGEN(j)  (2304 + 64 * (j))
#define XB_TOP      3328
#define XB_TOPGEN   3392
#define XCD_BAR_WORDS 3456
#define XB_SPIN_CAP (1u << 18)

__device__ __forceinline__ unsigned xb_ld(unsigned* p)              { return __hip_atomic_load(p, __ATOMIC_RELAXED, __HIP_MEMORY_SCOPE_AGENT); }
__device__ __forceinline__ unsigned xb_add(unsigned* p, unsigned v) { return __hip_atomic_fetch_add(p, v, __ATOMIC_RELAXED, __HIP_MEMORY_SCOPE_AGENT); }
__device__ __forceinline__ unsigned xb_xcc_id() { return (unsigned)__builtin_amdgcn_s_getreg((3 << 11) | 20) & 0xFu; }
#define XB_SPIN(cond, bar) do { unsigned _sp = 0; while (cond) { __builtin_amdgcn_s_sleep(1); \
    if ((++_sp & 255u) == 0u) { if (xb_ld(&(bar)[XB_TMO])) break; if (_sp > XB_SPIN_CAP) { atomicAdd(&(bar)[XB_TMO], 1u); break; } } } } while (0)

struct XcdBarrier {
    unsigned* bar; unsigned x;
    volatile LAS unsigned* st;
};

__device__ __forceinline__ XcdBarrier xcd_barrier_post(unsigned* bar, volatile LAS unsigned* st) {
    XcdBarrier b; b.bar = bar; b.x = xb_xcc_id(); b.st = st;
    if (threadIdx.x == 0) (void)xb_add(&bar[XB_XCNT(b.x)], 1u);
    return b;
}
__device__ __forceinline__ void xcd_barrier_complete(unsigned* bar, unsigned x, unsigned& nloc, unsigned& nx) {
    const unsigned G = gridDim.x * gridDim.y * gridDim.z;
    unsigned sum, cnt, mine, sp = 0u;
    for (;;) {
        sum = 0u; cnt = 0u; mine = 0u;
#pragma unroll
        for (unsigned j = 0; j < 16; ++j) { const unsigned c = xb_ld(&bar[XB_XCNT(j)]); sum += c; cnt += (c > 0u) ? 1u : 0u; mine = (j == x) ? c : mine; }
        if (sum == G) break;
        __builtin_amdgcn_s_sleep(1);
        if ((++sp & 255u) == 0u) { if (xb_ld(&bar[XB_TMO])) break; if (sp > XB_SPIN_CAP) { atomicAdd(&bar[XB_TMO], 1u); break; } }
    }
    nloc = mine > 0u ? mine : 1u; nx = cnt > 0u ? cnt : 1u;
}

__device__ __forceinline__ void xcd_barrier(const XcdBarrier& b) {
    asm volatile("s_waitcnt vmcnt(0)" ::: "memory");
    __syncthreads();
    if (threadIdx.x == 0) {
        unsigned* bar = b.bar;
        __builtin_amdgcn_s_waitcnt(0);
        unsigned nloc = b.st[0], nx = b.st[1];
        if (nloc == 0u) { xcd_barrier_complete(bar, b.x, nloc, nx); b.st[0] = nloc; b.st[1] = nx; }
        const unsigned old = xb_add(&bar[XB_XSUB(b.x)], 1u);
        const unsigned gen = old / nloc;
        if (old + 1u == (gen + 1u) * nloc) {
            __builtin_amdgcn_fence(__ATOMIC_RELEASE, "agent");
            asm volatile("s_waitcnt vmcnt(0)" ::: "memory");
            const unsigned og = xb_add(&bar[XB_TOP], 1u);
            const unsigned tg = og / nx;
            if (og + 1u == (tg + 1u) * nx) xb_add(&bar[XB_TOPGEN], 1u);
            else XB_SPIN(xb_ld(&bar[XB_TOPGEN]) == tg, bar);
            __builtin_amdgcn_fence(__ATOMIC_ACQUIRE, "agent");
            xb_add(&bar[XB_XGEN(b.x)], 1u);
            asm volatile("s_waitcnt vmcnt(0)" ::: "memory");
        } else {
            XB_SPIN(xb_ld(&bar[XB_XGEN(b.x)]) == gen, bar);
            __builtin_amdgcn_fence(__ATOMIC_ACQUIRE, "agent");
            asm volatile("s_waitcnt vmcnt(0)" ::: "memory");
        }
    }
    __syncthreads();
}

__device__ __forceinline__ void grid_seam_cg(cg::grid_group& grid) {
    asm volatile("s_waitcnt vmcnt(0) lgkmcnt(0)" ::: "memory");
    __syncthreads();
    if (threadIdx.x == 0) asm volatile("buffer_wbl2 sc1\n\ts_waitcnt vmcnt(0)" ::: "memory");
    grid.sync();
    asm volatile("buffer_inv sc1\n\ts_waitcnt vmcnt(0)" ::: "memory");
}
__global__ void __launch_bounds__(NTHR, 2) mega_fwd(Args args) {
    extern __shared__ __attribute__((aligned(16))) unsigned char lds_raw[];
    cg::grid_group grid = cg::this_grid();
    const ldsp lds = (ldsp)lds_raw;
    const int tid = threadIdx.x, lane = tid & 63, wave = __builtin_amdgcn_readfirstlane(tid >> 6);
    const int G = gridDim.x, bx = blockIdx.x;
    unsigned char* ws = args.ws;
    unsigned* ctl = (unsigned*)(ws + WS_CTL);
    float* ctlf = (float*)(ws + WS_CTL);
    unsigned long long* SS = (unsigned long long*)(ws + WS_SS);
    bf16_t* XB = (bf16_t*)(ws + WS_XB);
    bf16_t* Zb = (bf16_t*)(ws + WS_Z);
    _Float16* Gb = (_Float16*)(ws + WS_G);
    bf16_t* Ub = (bf16_t*)(ws + WS_U);
    bf16_t* MIXb = (bf16_t*)(ws + WS_MIX);
    const float* x_in = args.in[0];
    float* X = args.out;
    LAS int* const sh_idx = (LAS int*)(lds + LDS_BYTES - 16);
    if (tid < 8) *(LAS unsigned*)(lds + LDS_BYTES - 32 + 4 * tid) = 0u;
    __syncthreads();
    const XcdBarrier xbar = xcd_barrier_post(ctl + CW_BAR, (volatile LAS unsigned*)(lds + LDS_BYTES - 32));

    {
        const int gw = bx * NWAVES + wave, NGW = G * NWAVES;
        LAS float* scr = (LAS float*)(lds + wave * 16384);
        constexpr int I_TOT = DEPTH * ((DM / 64) * (INC / 32) + (DM / 64) * (DM / 32) + (DM / 64) * (FF / 32) + (FF / 64) * (DM / 32));
        { f32x4 wv[8], wn[8]; float gg[8], gn[8];
          P0Item cur = p0_decode(args, ws, gw < I_TOT ? gw : 0), nxt = cur;
          if (gw < I_TOT) p0_load(cur, lane, wv, gg);
#pragma unroll 1
          for (int it = gw; it < I_TOT; it += NGW) {
              const bool has = (it + NGW < I_TOT);
              if (has) { nxt = p0_decode(args, ws, it + NGW); p0_load(nxt, lane, wn, gn); }
              p0_store(cur, lane, scr, wv, gg);
              if (has) { cur = nxt;
#pragma unroll
                  for (int i = 0; i < 8; ++i) { wv[i] = wn[i]; gg[i] = gn[i]; } }
          } }
        { f32x4 v[4], vn[4];
          if (gw < M_TOK) { const f32x4* xr = (const f32x4*)(x_in + (size_t)gw * DM) + lane;
#pragma unroll
              for (int j = 0; j < 4; ++j) v[j] = __builtin_nontemporal_load(xr + 64 * j); }
#pragma unroll 1
          for (int m = gw; m < M_TOK; m += NGW) {
              const bool has = (m + NGW < M_TOK);
              if (has) { const f32x4* xr = (const f32x4*)(x_in + (size_t)(m + NGW) * DM) + lane;
#pragma unroll
                  for (int j = 0; j < 4; ++j) vn[j] = __builtin_nontemporal_load(xr + 64 * j); }
              float s2 = 0.f;
#pragma unroll
              for (int j = 0; j < 4; ++j) s2 += (v[j].x * v[j].x + v[j].y * v[j].y) + (v[j].z * v[j].z + v[j].w * v[j].w);
              s2 = wave_sum(s2);
              u32x2* o8 = (u32x2*)(XB + (size_t)m * DM) + lane;
#pragma unroll
              for (int j = 0; j < 4; ++j) { u32x2 wv2; wv2.x = cvtpk(v[j].x, v[j].y); wv2.y = cvtpk(v[j].z, v[j].w); o8[64 * j] = wv2; }
              if (lane == 0) SS[m] = (unsigned long long)(s2 * pg8::SS_FIX);
              if (has) {
#pragma unroll
                  for (int j = 0; j < 4; ++j) v[j] = vn[j]; }
          } }
        for (int i = bx * NTHR + tid; i < 8 * M_TOK; i += G * NTHR) SS[M_TOK + i] = 0ull;
        if (bx == 0) {
            { const float* lg = args.in[5]; const int c = tid;
              const float a0 = lg[c], a1 = lg[512 + c], a2 = lg[1024 + c], a3 = lg[1536 + c];
              const float mx = fmaxf(fmaxf(a0, a1), fmaxf(a2, a3));
              const float e0 = expf(a0 - mx), e1 = expf(a1 - mx), e2 = expf(a2 - mx), e3 = expf(a3 - mx);
              const float inv = 1.0f / ((e0 + e1) + (e2 + e3));
              ctlf[CW_LB + c] = 0.f; ctlf[CW_LB + 512 + c] = e1 * inv; ctlf[CW_LB + 1024 + c] = (e1 + e2) * inv; ctlf[CW_LB + 1536 + c] = (e1 + e2 + e3) * inv; }
            if (wave < DEPTH) {
                const float* lq = args.in[3] + wave * 256;
                const float p1 = wave_sum(lq[lane] * lq[64 + lane]), p2 = wave_sum(lq[128 + lane] * lq[192 + lane]);
                if (lane == 0) ctlf[CW_LAM + wave] = expf(p1) - expf(p2) + (0.8f - 0.6f * expf(-0.3f * (float)wave));
            }
        }
    }
    if (args.ws == nullptr) grid_seam_cg(grid);
    xcd_barrier(xbar);

#pragma unroll 1
    for (int step = 0; step < 7 * DEPTH; ++step) {
        const int l = step / 7, ph = step - 7 * l;
        unsigned char* wl = ws + WS_W + (size_t)l * W_LAYER;
        unsigned long long* ss1 = SS + (size_t)(2 * l) * M_TOK;
        unsigned long long* ss2 = SS + (size_t)(2 * l + 1) * M_TOK;
        unsigned long long* ss3 = SS + (size_t)(2 * l + 2) * M_TOK;
        bf16_t* TSb = (bf16_t*)args.out; float* SCb = (float*)(ws + WS_SC);
        const float* gnh = args.in[6] + l * 128;
#ifndef PROBE_REPEAT_PH
#define PROBE_REPEAT_PH -1
#endif
#ifndef PROBE_LITE
#define PROBE_LITE 0
#endif
#pragma unroll 1
        for (int rep = 0; rep < (ph == PROBE_REPEAT_PH ? 2 : 1); ++rep) {
        if (ph == 1) {
            hgrn_chunk<1>(lds, bx, G, Zb, Gb, TSb, SCb, MIXb, gnh);
        } else if (ph == 3) {
            hgrn_chunk<3>(lds, bx, G, Zb, Gb, TSb, SCb, MIXb, gnh, PROBE_LITE * rep);
        } else if (ph == 2) {
            const float lam = ctlf[CW_LAM + l];
            const float oscale = 1.0f - (0.8f - 0.6f * expf(-0.3f * (float)l));
            const float* relb = args.in[11];
            const float* gna = args.in[4] + l * 128;
            const int xcc = (int)(xb_xcc_id() & 7u);
            attn_bias_tables(lds, relb);
#pragma unroll 1
            for (int qi = 0; qi < 8; ++qi) {
                const int xq = (xcc + qi) & 7;
                unsigned* qctr = ctl + CW_QCTR + 64 * ((l + DEPTH * rep) * 8 + xq);
                for (;;) {
                    if (tid == 0) *sh_idx = (rep ? 4 : 0) + (int)__hip_atomic_fetch_add(qctr, 1u, __ATOMIC_RELAXED, __HIP_MEMORY_SCOPE_AGENT);
                    __syncthreads();
                    const int idx = *sh_idx;
                    __syncthreads();
                    if (idx >= 4 + 128) break;
#ifdef PROBE_SCAN_LAST
                    if (idx >= 128) hgrn_scan(4 * xq + idx - 128, TSb, SCb);
                    else { const int a = idx, pr = a >> 6,
#else
                    if (idx < 4) hgrn_scan(4 * xq + idx, TSb, SCb);
                    else { const int a = idx - 4, pr = a >> 6,
#endif
                           qb = 31 - ((a & 63) >> 1), bh = 4 * xq + 2 * pr + (a & 1);
#ifdef PROBE_ATT
                           if (rep) attn_unit<PROBE_ATT>(lds, bh >> 2, bh & 3, qb, Zb, MIXb, relb, gna, lam, oscale); else
#endif
                           attn_unit<0>(lds, bh >> 2, bh & 3, qb, Zb, MIXb, relb, gna, lam, oscale); }
                }
            }
        } else {
            pg8::Gemm g; pg8::EpiAny E{};
            if (ph == 0)      { g = pg8::Gemm{XB, (const bf16_t*)(wl + W_IN), M_TOK, INC, DM}; E.mode = 0; E.Z = Zb; E.G = Gb; E.ss = ss1; E.lb = ctlf + CW_LB + 512 * l; }
            else if (ph == 4) { g = pg8::Gemm{MIXb, (const bf16_t*)(wl + W_OUT), M_TOK, DM, DM}; E.mode = 1; E.ascale = 1.0f; E.xb = XB; E.ssn = ss2; }
            else if (ph == 5) { g = pg8::Gemm{XB, (const bf16_t*)(wl + W_UP), M_TOK, FF, DM}; E.mode = 2; E.Z = Ub; E.ss = ss2; }
            else              { g = pg8::Gemm{Ub, (const bf16_t*)(wl + W_DOWN), M_TOK, DM, FF, 1}; E.mode = 1; E.ascale = 1.0f; E.xb = XB; E.ssn = ss3; }
            pg8::StaticOrder S; S.init(M_TOK, g.N, G, bx, ph == 6);
            pg8::gemm_phase<pg8::EpiAny, pg8::StaticOrder, true, true>(lds, g, S, E);
        }
        xcd_barrier(xbar);
#ifdef PROBE_SEAM2
        xcd_barrier(xbar);
#endif
        }
    }
    {
        const int gw = bx * NWAVES + wave, NGW = G * NWAVES;
        const float* fg = args.in[12];
        const unsigned long long* ssf = SS + (size_t)8 * M_TOK;
        f32x4 gv[4];
#pragma unroll
        for (int j = 0; j < 4; ++j) gv[j] = ((const f32x4*)fg)[lane + 64 * j];
        for (int m = gw; m < M_TOK; m += NGW) {
            const u32x2* xr = (const u32x2*)(XB + (size_t)m * DM) + lane;
            f32x4* orow = (f32x4*)(X + (size_t)m * DM) + lane;
            const float rs = rsqrtf((float)ssf[m] * pg8::SS_INV + 1e-6f);
#pragma unroll
            for (int j = 0; j < 4; ++j) { const u32x2 xw = __builtin_nontemporal_load(xr + 64 * j);
                const f32x4 v = {__uint_as_float(xw.x << 16), __uint_as_float(xw.x & 0xffff0000u), __uint_as_float(xw.y << 16), __uint_as_float(xw.y & 0xffff0000u)};
                __builtin_nontemporal_store(v * rs * gv[j], orow + 64 * j); }
        }
    }
}

extern "C" void kernel_launch(void* const* d_in, const int* in_sizes, int n_in, void* d_out, int out_size, void* d_ws, size_t ws_size, hipStream_t stream) {
    static int grid = 0;
    if (grid == 0) {
        if (n_in != 13 || ws_size < WS_END) { fprintf(stderr, "kernel_launch: unexpected n_in %d / ws_size %zu (need %zu)\n", n_in, ws_size, (size_t)WS_END); grid = -1; return; }
        int dev = 0, cus = 0, per_cu = 0;
        hipGetDevice(&dev);
        hipDeviceGetAttribute(&cus, hipDeviceAttributeMultiprocessorCount, dev);
        if (hipFuncSetAttribute((const void*)mega_fwd, hipFuncAttributeMaxDynamicSharedMemorySize, LDS_BYTES) != hipSuccess) { fprintf(stderr, "kernel_launch: hipFuncSetAttribute failed\n"); grid = -1; return; }
        if (hipOccupancyMaxActiveBlocksPerMultiprocessor(&per_cu, (const void*)mega_fwd, NTHR, LDS_BYTES) != hipSuccess || per_cu < 1) { fprintf(stderr, "kernel_launch: occupancy query says %d\n", per_cu); per_cu = 1; }
        (void)hipGetLastError();
        grid = cus * 1;
    }
    if (grid < 0) return;
    if (hipMemsetAsync((char*)d_ws + WS_CTL, 0, CTL_ZERO_BYTES, stream) != hipSuccess) { fprintf(stderr, "kernel_launch: hipMemsetAsync failed\n"); return; }
    Args a{};
    for (int i = 0; i < 13; ++i) a.in[i] = (const float*)d_in[i];
    a.out = (float*)d_out; a.ws = (unsigned char*)d_ws;
    void* kargs[] = {&a};
    hipError_t e = hipLaunchCooperativeKernel((const void*)mega_fwd, dim3(grid), dim3(NTHR), kargs, LDS_BYTES, stream);
    if (e != hipSuccess) fprintf(stderr, "kernel_launch: cooperative launch failed: %s (grid %d)\n", hipGetErrorString(e), grid);
}
```
